# Optimizing an MI355X kernel written in HIP

```python
import jax, jax.numpy as jnp
from jax import lax
import numpy as np

D_MODEL = 1024
BATCH = 16
SEQ = 4096
DEPTH = 1

FOX_HEAD_DIM = 64
FOX_WIDTH = D_MODEL // 2
FOX_HEADS = FOX_WIDTH // FOX_HEAD_DIM
Q_BLOCK = 128
MLSTM_HEADS = 4
MLSTM_WIDTH = D_MODEL // 2
MLSTM_HEAD_DIM = MLSTM_WIDTH // MLSTM_HEADS
CONV_WIDTH = 4
CHUNK = 128
D_FF = -(-8 * D_MODEL // (3 * 256)) * 256
EPS = 1e-6

IN_SPLIT_SIZES = (
    FOX_WIDTH, FOX_WIDTH, FOX_WIDTH, FOX_HEADS,
    MLSTM_WIDTH, MLSTM_WIDTH, MLSTM_WIDTH, MLSTM_HEADS, MLSTM_HEADS,
    MLSTM_WIDTH,
    D_MODEL, D_MODEL,
)
IN_WIDTH = sum(IN_SPLIT_SIZES)

kernel_name = 'fox_mlstm_gated_hybrid_block'


def rms_norm(x, g):
    xf = x.astype(jnp.float32)
    y = xf * lax.rsqrt(jnp.mean(xf * xf, axis=-1, keepdims=True) + EPS)
    return (y * g.astype(jnp.float32)).astype(x.dtype)


def head_layer_norm(x, g):
    B, S, H, d = x.shape
    xf = x.astype(jnp.float32)
    mu = jnp.mean(xf, axis=-1, keepdims=True)
    xc = xf - mu
    y = xc * lax.rsqrt(jnp.mean(xc * xc, axis=-1, keepdims=True) + EPS)
    return y.reshape(B, S, H * d) * g.astype(jnp.float32)


def causal_conv_silu(u, w, b):
    S = u.shape[1]
    up = jnp.pad(u, ((0, 0), (CONV_WIDTH - 1, 0), (0, 0)))
    y = b + sum(w[j] * up[:, j:j + S] for j in range(CONV_WIDTH))
    return jax.nn.silu(y)


def fox_attention(q, k, v, logf):
    B, S, H, d = q.shape
    nb = S // Q_BLOCK
    scale = d ** -0.5
    c = jnp.cumsum(logf, axis=1).transpose(0, 2, 1)
    q_blocks = q.reshape(B, nb, Q_BLOCK, H, d).transpose(1, 0, 2, 3, 4)
    c_blocks = c.reshape(B, H, nb, Q_BLOCK).transpose(2, 0, 1, 3)
    k_pos = jnp.arange(S)

    def block(args):
        qi, ci, bi = args
        s = jnp.einsum('bqhd,bkhd->bhqk', qi, k).astype(jnp.float32) * scale
        s = s + ci[..., :, None] - c[:, :, None, :]
        q_pos = bi * Q_BLOCK + jnp.arange(Q_BLOCK)
        s = jnp.where(k_pos[None, :] <= q_pos[:, None], s, -jnp.inf)
        p = jax.nn.softmax(s, axis=-1).astype(v.dtype)
        return jnp.einsum('bhqk,bkhd->bqhd', p, v)

    out = lax.map(block, (q_blocks, c_blocks, jnp.arange(nb)))
    return out.transpose(1, 0, 2, 3, 4).reshape(B, S, H, d)


def mlstm_chunkwise(q, k, v, logi, logf):
    B, S, H, d = q.shape
    nc = S // CHUNK
    f32 = jnp.float32

    def to_chunks(t):
        return t.astype(f32).reshape(B, nc, CHUNK, H, -1).transpose(1, 0, 3, 2, 4)

    qc = to_chunks(q)
    kc = to_chunks(k) * (d ** -0.5)
    vc = to_chunks(v)
    ic = to_chunks(logi[..., None])[..., 0]
    fc = to_chunks(logf[..., None])[..., 0]
    causal = jnp.tril(jnp.ones((CHUNK, CHUNK), dtype=bool))

    def step(carry, inp):
        C, n, m = carry
        qi, ki, vi, li, lf = inp
        b = jnp.cumsum(lf, axis=-1)
        a = b + m[..., None]
        D = jnp.where(causal, b[..., :, None] - b[..., None, :] + li[..., None, :], -jnp.inf)
        m_t = jnp.maximum(a, jnp.max(D, axis=-1))
        w_inter = jnp.exp(a - m_t)
        w_intra = jnp.exp(D - m_t[..., None])
        s = jnp.einsum('bhtd,bhsd->bhts', qi, ki) * w_intra
        num = w_inter[..., None] * jnp.einsum('bhvk,bhtk->bhtv', C, qi) + jnp.einsum('bhts,bhsv->bhtv', s, vi)
        den = w_inter * jnp.einsum('bhk,bhtk->bht', n, qi) + jnp.sum(s, axis=-1)
        h = num / jnp.maximum(jnp.abs(den), jnp.exp(-m_t))[..., None]
        m_new = m_t[..., -1]
        w_state = jnp.exp(b[..., -1:] - b + li - m_new[..., None])
        decay = jnp.exp(b[..., -1] + m - m_new)
        C_new = decay[..., None, None] * C + jnp.einsum('bhs,bhsv,bhsk->bhvk', w_state, vi, ki)
        n_new = decay[..., None] * n + jnp.einsum('bhs,bhsk->bhk', w_state, ki)
        return (C_new, n_new, m_new), h

    init = (jnp.zeros((B, H, d, d), f32), jnp.zeros((B, H, d), f32), jnp.zeros((B, H), f32))
    _, h = lax.scan(step, init, (qc, kc, vc, ic, fc))
    return h.transpose(1, 0, 3, 2, 4).reshape(B, S, H, d)


def hybrid_mixer(x, g_mix, w_in, b_fox_f, g_q_fox, g_k_fox, conv_w, conv_b,
                 b_mlstm_i, b_mlstm_f, g_mlstm_h, w_fox_out, w_mlstm_out, w_o):
    B, S, _ = x.shape
    h = rms_norm(x, g_mix)
    proj = h @ w_in
    split_points = [int(p) for p in np.cumsum(IN_SPLIT_SIZES)[:-1]]
    (qa, ka, va, fa, qb, kb, vb, ib, fb, ob, ga, gb) = jnp.split(proj, split_points, axis=-1)

    qa = rms_norm(qa.reshape(B, S, FOX_HEADS, FOX_HEAD_DIM), g_q_fox)
    ka = rms_norm(ka.reshape(B, S, FOX_HEADS, FOX_HEAD_DIM), g_k_fox)
    va = va.reshape(B, S, FOX_HEADS, FOX_HEAD_DIM)
    logf_a = jax.nn.log_sigmoid((fa + b_fox_f).astype(jnp.float32))
    ya = fox_attention(qa, ka, va, logf_a).reshape(B, S, FOX_WIDTH)

    qkb = causal_conv_silu(jnp.concatenate([qb, kb], axis=-1), conv_w, conv_b)
    qb, kb = jnp.split(qkb, 2, axis=-1)
    qb = qb.reshape(B, S, MLSTM_HEADS, MLSTM_HEAD_DIM)
    kb = kb.reshape(B, S, MLSTM_HEADS, MLSTM_HEAD_DIM)
    vb = vb.reshape(B, S, MLSTM_HEADS, MLSTM_HEAD_DIM)
    logi_b = (ib + b_mlstm_i).astype(jnp.float32)
    logf_b = jax.nn.log_sigmoid((fb + b_mlstm_f).astype(jnp.float32))
    hb = mlstm_chunkwise(qb, kb, vb, logi_b, logf_b)
    yb = (head_layer_norm(hb, g_mlstm_h) * jax.nn.sigmoid(ob.astype(jnp.float32))).astype(x.dtype)

    merged = jax.nn.sigmoid(ga) * (ya @ w_fox_out) + jax.nn.sigmoid(gb) * (yb @ w_mlstm_out)
    return merged @ w_o


def swiglu_ffn(x, g_ffn, w_gate, w_up, w_down):
    h = rms_norm(x, g_ffn)
    return (jax.nn.silu(h @ w_gate) * (h @ w_up)) @ w_down


def setup_inputs(seed: int = 0) -> dict:
    key = jax.random.key(seed)
    ks = jax.random.split(key, 20)

    def nrm(k, shape, scale):
        return jax.random.normal(k, shape, jnp.float32) * scale

    return {
        'x': nrm(ks[0], (BATCH, SEQ, D_MODEL), 1.0),
        'g_mix': 1.0 + nrm(ks[1], (DEPTH, D_MODEL), 0.02),
        'w_in': nrm(ks[2], (DEPTH, D_MODEL, IN_WIDTH), D_MODEL ** -0.5),
        'b_fox_f': jnp.linspace(1.0, 4.0, FOX_HEADS)[None, :] + nrm(ks[3], (DEPTH, FOX_HEADS), 0.01),
        'g_q_fox': 1.0 + nrm(ks[4], (DEPTH, FOX_HEAD_DIM), 0.02),
        'g_k_fox': 1.0 + nrm(ks[5], (DEPTH, FOX_HEAD_DIM), 0.02),
        'conv_w': nrm(ks[6], (DEPTH, CONV_WIDTH, 2 * MLSTM_WIDTH), CONV_WIDTH ** -0.5),
        'conv_b': nrm(ks[7], (DEPTH, 2 * MLSTM_WIDTH), 0.01),
        'b_mlstm_i': nrm(ks[8], (DEPTH, MLSTM_HEADS), 0.1),
        'b_mlstm_f': jnp.linspace(3.0, 6.0, MLSTM_HEADS)[None, :] + nrm(ks[9], (DEPTH, MLSTM_HEADS), 0.01),
        'g_mlstm_h': 1.0 + nrm(ks[10], (DEPTH, MLSTM_WIDTH), 0.02),
        'w_fox_out': nrm(ks[11], (DEPTH, FOX_WIDTH, D_MODEL), FOX_WIDTH ** -0.5),
        'w_mlstm_out': nrm(ks[12], (DEPTH, MLSTM_WIDTH, D_MODEL), MLSTM_WIDTH ** -0.5),
        'w_o': nrm(ks[13], (DEPTH, D_MODEL, D_MODEL), D_MODEL ** -0.5),
        'g_ffn': 1.0 + nrm(ks[14], (DEPTH, D_MODEL), 0.02),
        'w_gate': nrm(ks[15], (DEPTH, D_MODEL, D_FF), D_MODEL ** -0.5),
        'w_up': nrm(ks[16], (DEPTH, D_MODEL, D_FF), D_MODEL ** -0.5),
        'w_down': nrm(ks[17], (DEPTH, D_FF, D_MODEL), D_FF ** -0.5),
    }


def reference(x, g_mix, w_in, b_fox_f, g_q_fox, g_k_fox, conv_w, conv_b, b_mlstm_i, b_mlstm_f,
              g_mlstm_h, w_fox_out, w_mlstm_out, w_o, g_ffn, w_gate, w_up, w_down):
    for l in range(DEPTH):
        x = x + hybrid_mixer(x, g_mix[l], w_in[l], b_fox_f[l], g_q_fox[l], g_k_fox[l], conv_w[l], conv_b[l],
                             b_mlstm_i[l], b_mlstm_f[l], g_mlstm_h[l], w_fox_out[l], w_mlstm_out[l], w_o[l])
        x = x + swiglu_ffn(x, g_ffn[l], w_gate[l], w_up[l], w_down[l])
    return x
```

```cpp
#include <hip/hip_runtime.h>
#include <hip/hip_cooperative_groups.h>
#include <cstdio>
#include <cstdint>
#include <cmath>
namespace cg = cooperative_groups;
namespace pg8 {
#define PG8_LAS __attribute__((address_space(3)))
typedef unsigned short bf16_t;
typedef short bf16x8 __attribute__((ext_vector_type(8)));
typedef float f32x4 __attribute__((ext_vector_type(4)));
typedef unsigned u32x4 __attribute__((ext_vector_type(4)));
constexpr int BM = 256, BK = 64, HALF = 128, HTB = HALF * BK * 2  , STAGE_BYTES = 8 * HTB, NXCD = 8, WGM = 8;

__host__ __device__ __forceinline__ int lds_byte(int r, int c) { const int st = (r >> 4) * 2 + (c >> 5), rr = r & 15, cc = c & 31, ob = rr * 64 + cc * 2; return st * 1024 + (ob ^ (((ob >> 9) & 1) << 5)); }
__host__ __device__ __forceinline__ void stage_rc(int b, int& R, int& C) { const int st = b / 1024, sb = b % 1024, swz = sb ^ (((sb >> 9) & 1) << 5); R = (st >> 1) * 16 + swz / 64; C = (st & 1) * 32 + (swz % 64) / 2; }
__host__ __device__ __forceinline__ int perm32(int rho) { const int n = rho >> 4, i = rho & 15; return 8 * (i >> 2) + 4 * n + (i & 3); }

struct Unit { int pm, pn; };
struct Gemm { const bf16_t* A; const bf16_t* Bt; int M, N, K; };

struct StaticOrder {
    int nM, nN, nwg, G, c;
    __host__ __device__ void init(int M, int N, int G_, int c_) { nM = M / BM; nN = N / BM; nwg = nM * nN; G = G_; c = c_; }
    __host__ __device__ bool next(int i, Unit& u) const {
        const long L = (long)i * G + c; if (L >= nwg) return false;
        int wgid = (int)L; { const int q = nwg / NXCD, r = nwg % NXCD, xcd = wgid % NXCD, off = wgid / NXCD; wgid = (xcd < r ? xcd * (q + 1) : r * (q + 1) + (xcd - r) * q) + off; }
        const int nig = WGM * nN, gid = wgid / nig, fm = gid * WGM, gsz = (nM - fm) < WGM ? (nM - fm) : WGM;
        u.pm = fm + ((wgid % nig) % gsz); u.pn = (wgid % nig) / gsz; return true;
    }
    __device__ __forceinline__ void a_ready(const Unit&) const {}
    __device__ __forceinline__ void done(const Unit&) const {}
};

__device__ __forceinline__ unsigned cvt_pk_bf16(float lo, float hi) { unsigned r; asm volatile("v_cvt_pk_bf16_f32 %0, %1, %2" : "=v"(r) : "v"(lo), "v"(hi)); return r; }
typedef float f32x2 __attribute__((ext_vector_type(2)));
template <class Epi, class Sched, bool ALIGN_EPI = false, bool SP2 = false>
__device__ __forceinline__ void gemm_phase(PG8_LAS unsigned char* lds, const Gemm g, const Sched& S, const Epi& E, const int wid  ) {
    int lane = __builtin_amdgcn_mbcnt_hi(~0u, __builtin_amdgcn_mbcnt_lo(~0u, 0u)); asm volatile("" : "+v"(lane));
    const int tid = wid * 64 + lane, wr = wid >> 2, wc = wid & 3, fr = lane & 15, fq = lane >> 4;
    const int K = g.K, nt = K / BK;
    unsigned voffA[2], voffB[2];
#pragma unroll
    for (int i = 0; i < 2; ++i) { int R, C; stage_rc(tid * 16 + i * 8192, R, C); const int Rb = Epi::PERM ? ((R & ~31) + perm32(R & 31)) : R;
        voffA[i] = (unsigned)(R * K + C) * 2u; voffB[i] = (unsigned)(Rb * K + C) * 2u; }
    const size_t kstep = (size_t)(BK * 2);
    const size_t hstep = (size_t)HALF * K * 2;
    const size_t tstep = 2 * hstep;
    const unsigned ldsw = (unsigned)wid * 1024u;
    const int aoff = lds_byte(wr * 64 + fr, fq * 8), boff = lds_byte(wc * 32 + fr, fq * 8);
#define PG8_SA(b, h) (((b) * 2 + (h)) * HTB)
#define PG8_SB(b, h) ((4 + (b) * 2 + (h)) * HTB)
#define PG8_STAGE(bufoff, gbase, voff) do { _Pragma("unroll") for (int _i = 0; _i < 2; ++_i) \
        __builtin_amdgcn_global_load_lds((const unsigned*)((const char*)(gbase) + (voff)[_i]), (PG8_LAS unsigned*)(lds + (bufoff) + ldsw + _i * 8192), 16, 0, 0); } while (0)
#define PG8_LDA(dst, b, h) do { _Pragma("unroll") for (int m = 0; m < 4; ++m) _Pragma("unroll") for (int k = 0; k < 2; ++k) dst[m][k] = *(const PG8_LAS bf16x8*)(lds + PG8_SA(b, h) + aoff + m * 2048 + k * 1024); } while (0)
#define PG8_LDB(dst, b, h) do { _Pragma("unroll") for (int n = 0; n < 2; ++n) _Pragma("unroll") for (int k = 0; k < 2; ++k) dst[n][k] = *(const PG8_LAS bf16x8*)(lds + PG8_SB(b, h) + boff + n * 2048 + k * 1024); } while (0)
#define PG8_MMA(ai, bj, At, Bt) do { __builtin_amdgcn_s_setprio(1); _Pragma("unroll") for (int m = 0; m < 4; ++m) _Pragma("unroll") for (int n = 0; n < 2; ++n) _Pragma("unroll") for (int k = 0; k < 2; ++k) \
        acc[ai][bj][m][n] = __builtin_amdgcn_mfma_f32_16x16x32_bf16(Bt[n][k], At[m][k], acc[ai][bj][m][n], 0, 0, 0); __builtin_amdgcn_s_setprio(0); } while (0)
#define PG8_WAIT_V(n) asm volatile("s_waitcnt vmcnt(" #n ")" ::: "memory")
#define PG8_WAIT_L(n) asm volatile("s_waitcnt lgkmcnt(" #n ")" ::: "memory")
#define PG8_BAR __builtin_amdgcn_s_barrier()
#define PG8_SCHED __builtin_amdgcn_sched_barrier(0)
    Unit cur, nxt; int ui = 0;
    if (!S.next(0, cur)) return;
    f32x4 acc[2][2][4][2];
#pragma unroll
    for (int a = 0; a < 2; ++a)
#pragma unroll
        for (int b = 0; b < 2; ++b)
#pragma unroll
            for (int m = 0; m < 4; ++m)
#pragma unroll
                for (int n = 0; n < 2; ++n) acc[a][b][m][n] = (f32x4){0.f, 0.f, 0.f, 0.f};
    bf16x8 At[4][2], B0[2][2], B1[2][2];
    const char* cA = (const char*)g.A + (size_t)cur.pm * tstep; const char* cB = (const char*)g.Bt + (size_t)cur.pn * tstep;
    S.a_ready(cur);
    if constexpr (SP2) {
        PG8_STAGE(PG8_SB(0, 0), cB, voffB); PG8_STAGE(PG8_SB(0, 1), cB + hstep, voffB); PG8_STAGE(PG8_SA(0, 0), cA, voffA); PG8_STAGE(PG8_SA(0, 1), cA + hstep, voffA);
        if (wr == 1) PG8_BAR;
        PG8_WAIT_V(2); PG8_BAR;
        PG8_STAGE(PG8_SB(1, 0), cB + kstep, voffB); PG8_STAGE(PG8_SA(1, 0), cA + kstep, voffA); PG8_STAGE(PG8_SB(1, 1), cB + hstep + kstep, voffB);
        PG8_WAIT_V(6); PG8_BAR;
    } else {
        PG8_STAGE(PG8_SB(0, 0), cB, voffB); PG8_STAGE(PG8_SA(0, 0), cA, voffA); PG8_STAGE(PG8_SB(0, 1), cB + hstep, voffB); PG8_STAGE(PG8_SA(0, 1), cA + hstep, voffA);
        if (wr == 1) PG8_BAR;
        PG8_WAIT_V(4); PG8_BAR;
        PG8_STAGE(PG8_SB(1, 0), cB + kstep, voffB); PG8_STAGE(PG8_SA(1, 0), cA + kstep, voffA); PG8_STAGE(PG8_SB(1, 1), cB + hstep + kstep, voffB);
        PG8_WAIT_V(6); PG8_BAR;
    }
    for (;;) {
        const bool has_next = S.next(ui + 1, nxt);
        const char* nA = has_next ? (const char*)g.A + (size_t)nxt.pm * tstep : cA; const char* nB = has_next ? (const char*)g.Bt + (size_t)nxt.pn * tstep : cB;
        for (int t = 0; t < nt; t += 2) {
            const bool last = (t == nt - 2);
            const char* a1 = cA + (size_t)(t + 1) * kstep;
            const char* a2 = last ? nA : cA + (size_t)(t + 2) * kstep; const char* b2 = last ? nB : cB + (size_t)(t + 2) * kstep;
            const char* a3 = a2 + kstep; const char* b3 = b2 + kstep;
            if (last && has_next) S.a_ready(nxt);
            if constexpr (SP2) {
            PG8_LDB(B0, 0, 0); PG8_LDB(B1, 0, 1); PG8_SCHED; PG8_LDA(At, 0, 0); PG8_STAGE(PG8_SA(1, 1), a1 + hstep, voffA);
            PG8_WAIT_V(8); PG8_WAIT_L(0); PG8_BAR; PG8_MMA(0, 0, At, B0); PG8_MMA(0, 1, At, B1); PG8_BAR; PG8_SCHED;
            PG8_LDA(At, 0, 1); PG8_STAGE(PG8_SB(0, 0), b2, voffB); PG8_STAGE(PG8_SB(0, 1), b2 + hstep, voffB); PG8_STAGE(PG8_SA(0, 0), a2, voffA);
            PG8_WAIT_V(8); PG8_WAIT_L(0); PG8_BAR; PG8_MMA(1, 0, At, B0); PG8_MMA(1, 1, At, B1); PG8_BAR; PG8_SCHED;
            PG8_LDB(B0, 1, 0); PG8_LDB(B1, 1, 1); PG8_SCHED; PG8_LDA(At, 1, 0); PG8_STAGE(PG8_SA(0, 1), a2 + hstep, voffA);
            PG8_WAIT_V(8); PG8_WAIT_L(0); PG8_BAR; PG8_MMA(0, 0, At, B0); PG8_MMA(0, 1, At, B1); PG8_BAR; PG8_SCHED;
            PG8_LDA(At, 1, 1); PG8_STAGE(PG8_SB(1, 0), b3, voffB); PG8_STAGE(PG8_SB(1, 1), b3 + hstep, voffB); PG8_STAGE(PG8_SA(1, 0), a3, voffA);
            PG8_WAIT_V(8); PG8_WAIT_L(0); PG8_BAR; PG8_MMA(1, 0, At, B0); PG8_MMA(1, 1, At, B1); PG8_BAR; PG8_SCHED;
            } else {
            PG8_LDB(B0, 0, 0); PG8_SCHED; PG8_LDA(At, 0, 0); PG8_STAGE(PG8_SA(1, 1), a1 + hstep, voffA);
            PG8_WAIT_L(8); PG8_BAR; PG8_WAIT_L(0); PG8_MMA(0, 0, At, B0); PG8_BAR; PG8_SCHED;
            PG8_LDB(B1, 0, 1); PG8_STAGE(PG8_SB(0, 0), b2, voffB);
            PG8_BAR; PG8_WAIT_L(0); PG8_MMA(0, 1, At, B1); PG8_BAR;
            PG8_LDA(At, 0, 1); PG8_STAGE(PG8_SA(0, 0), a2, voffA);
            PG8_BAR; PG8_WAIT_L(0); PG8_MMA(1, 0, At, B0); PG8_BAR; PG8_SCHED;
            PG8_STAGE(PG8_SB(0, 1), b2 + hstep, voffB);
            PG8_WAIT_V(6); PG8_BAR; PG8_MMA(1, 1, At, B1); PG8_BAR;
            PG8_LDB(B0, 1, 0); PG8_SCHED; PG8_LDA(At, 1, 0); PG8_STAGE(PG8_SA(0, 1), a2 + hstep, voffA);
            PG8_WAIT_L(8); PG8_BAR; PG8_WAIT_L(0); PG8_MMA(0, 0, At, B0); PG8_BAR; PG8_SCHED;
            PG8_LDB(B1, 1, 1); PG8_STAGE(PG8_SB(1, 0), b3, voffB);
            PG8_BAR; PG8_WAIT_L(0); PG8_MMA(0, 1, At, B1); PG8_BAR;
            PG8_LDA(At, 1, 1); PG8_STAGE(PG8_SA(1, 0), a3, voffA);
            PG8_BAR; PG8_WAIT_L(0); PG8_MMA(1, 0, At, B0); PG8_BAR; PG8_SCHED;
            PG8_STAGE(PG8_SB(1, 1), b3 + hstep, voffB);
            PG8_WAIT_V(6); PG8_BAR; PG8_MMA(1, 1, At, B1); PG8_BAR;
            }
        }
        if constexpr (ALIGN_EPI) { if (wr == 0) PG8_BAR; }
        if constexpr (!Epi::AFTER_DRAIN) { E(acc, cur, wr, wc, fr, fq); S.done(cur); }
        if (!has_next) break;
#pragma unroll
        for (int a = 0; a < 2; ++a)
#pragma unroll
            for (int b = 0; b < 2; ++b)
#pragma unroll
                for (int m = 0; m < 4; ++m)
#pragma unroll
                    for (int n = 0; n < 2; ++n) acc[a][b][m][n] = (f32x4){0.f, 0.f, 0.f, 0.f};
        cur = nxt; cA = nA; cB = nB; ++ui;
        if constexpr (ALIGN_EPI) { if (wr == 1) PG8_BAR; }
    }
    PG8_WAIT_V(0);
    if constexpr (!ALIGN_EPI) { if (wr == 0) PG8_BAR; }
    PG8_BAR;
    if constexpr (Epi::AFTER_DRAIN) { E.fused(acc, cur, wr, wc, fr, fq, lds, wid, lane); S.done(cur); }
#undef PG8_SA
#undef PG8_SB
#undef PG8_STAGE
#undef PG8_LDA
#undef PG8_LDB
#undef PG8_MMA
#undef PG8_WAIT_V
#undef PG8_WAIT_L
#undef PG8_BAR
#undef PG8_SCHED
}
}
#include <hip/hip_bf16.h>
#include <cmath>
namespace attn_body {
using bf16=__hip_bfloat16;
using bf16x8=__attribute__((ext_vector_type(8)))short;
using s16x4=__attribute__((ext_vector_type(4)))short;
using f32x16=__attribute__((ext_vector_type(16)))float;
using u32x4=__attribute__((ext_vector_type(4)))unsigned;
constexpr int BATCH=16,NHEAD=8,SEQ=4096,D=64,DM=NHEAD*D;
constexpr int NW=8,QBLK=32,QB=QBLK*NW,KVBLK=64,NQB=SEQ/QB;
constexpr int ATTN_PITCH=DM, ATTN_UNIT_ROWS=QB;
__device__ __forceinline__ int crow(int r,int hi){return (r&3)+8*(r>>2)+4*hi;}
#define SBAR() __builtin_amdgcn_sched_barrier(0)
__device__ __forceinline__ void cmask(f32x16&p0,f32x16&p1,int jb,int qrel,int hi){
  const float NEG=-INFINITY; int kb=64*jb+4*hi;
  #pragma unroll
  for(int r=0;r<16;++r){int kv=kb+(r&3)+8*(r>>2); if(kv>qrel)p0[r]=NEG; if(kv+32>qrel)p1[r]=NEG;}
}

constexpr int NSLOT=3, SLOTB=8192;
constexpr int LDS_K=0, LDS_V=NSLOT*SLOTB, LDS_WS=2*NSLOT*SLOTB, LDS_OST=LDS_WS+NW*64*4, LDS_BIAS=LDS_OST+NW*4096, LDS_BYTES=LDS_BIAS+SEQ*4;
constexpr float C2=0.125f*1.4426950408889634f;
__device__ __forceinline__ void glds16(const void*gsrc,unsigned lds_dst){unsigned keep;
  asm volatile("s_mov_b32 %0, m0\n\ts_mov_b32 m0, %2\n\ts_nop 0\n\tglobal_load_lds_dwordx4 %1, off\n\ts_mov_b32 m0, %0":"=&s"(keep):"v"(gsrc),"s"(lds_dst):"memory");}
__device__ __forceinline__ float max3f(float a,float b,float c){float r;asm("v_max3_f32 %0, %1, %2, %3":"=v"(r):"v"(a),"v"(b),"v"(c));return r;}
__device__ __forceinline__ float max2f(float a,float b){float r;asm("v_max_f32_e32 %0, %1, %2":"=v"(r):"v"(a),"v"(b));return r;}
__device__ __forceinline__ float fadd_s(float a,float b){float r;asm("v_add_f32_e32 %0, %1, %2":"=v"(r):"v"(a),"v"(b));return r;}
__device__ __forceinline__ float fsub_s(float a,float b){float r;asm("v_sub_f32_e32 %0, %1, %2":"=v"(r):"v"(a),"v"(b));return r;}
typedef float f32x2_t __attribute__((ext_vector_type(2))); typedef __bf16 bf16x2_t __attribute__((ext_vector_type(2)));
__device__ __forceinline__ unsigned cvtpk_s(float lo,float hi){f32x2_t v={lo,hi};bf16x2_t b=__builtin_convertvector(v,bf16x2_t);return __builtin_bit_cast(unsigned,b);}
#define WAIT_BAR(N) asm volatile("s_waitcnt vmcnt(" #N ") lgkmcnt(0)\n\ts_barrier":::"memory")

__device__ __forceinline__ void qkt(f32x16&p0,f32x16&p1,const char*Kslot,const bf16x8*qr,int r32,int hi){
  const char*kb=Kslot+hi*1024+r32*16;
  #pragma unroll
  for(int d0=0;d0<4;++d0){
    const bf16x8 b0=*reinterpret_cast<const bf16x8*>(kb+d0*2048);
    const bf16x8 b1=*reinterpret_cast<const bf16x8*>(kb+d0*2048+512);
    {p0=__builtin_amdgcn_mfma_f32_32x32x16_bf16(b0,qr[d0],p0,0,0,0);p1=__builtin_amdgcn_mfma_f32_32x32x16_bf16(b1,qr[d0],p1,0,0,0);}}
}
typedef __attribute__((address_space(3))) const char* lds_cptr;
typedef short v4i16_t __attribute__((ext_vector_type(4)));
__device__ __forceinline__ void kload8(bf16x8*kf,lds_cptr kp){
  kf[0]=*(const __attribute__((address_space(3))) bf16x8*)(kp);      kf[1]=*(const __attribute__((address_space(3))) bf16x8*)(kp+512);
  kf[2]=*(const __attribute__((address_space(3))) bf16x8*)(kp+2048); kf[3]=*(const __attribute__((address_space(3))) bf16x8*)(kp+2560);
  kf[4]=*(const __attribute__((address_space(3))) bf16x8*)(kp+4096); kf[5]=*(const __attribute__((address_space(3))) bf16x8*)(kp+4608);
  kf[6]=*(const __attribute__((address_space(3))) bf16x8*)(kp+6144); kf[7]=*(const __attribute__((address_space(3))) bf16x8*)(kp+6656);
}
__device__ __forceinline__ void kload2(bf16x8*kf,lds_cptr kp,int j){ kf[2*j]=*(const __attribute__((address_space(3))) bf16x8*)(kp+j*2048); kf[2*j+1]=*(const __attribute__((address_space(3))) bf16x8*)(kp+j*2048+512); }
__device__ __forceinline__ s16x4 vtr(lds_cptr p){ return __builtin_bit_cast(s16x4,__builtin_amdgcn_ds_read_tr16_b64_v4i16((__attribute__((address_space(3))) v4i16_t*)p)); }
__device__ __forceinline__ float rowmax(const f32x16&p0,const f32x16&p1){
  float a=max3f(p0[0],p0[1],p1[0]),b=max3f(p0[2],p0[3],p1[1]);a=max3f(a,p1[2],p1[3]);
  #pragma unroll
  for(int r=4;r<16;r+=4){a=max3f(a,p0[r],p0[r+1]);b=max3f(b,p0[r+2],p0[r+3]);a=max3f(a,p1[r],p1[r+1]);b=max3f(b,p1[r+2],p1[r+3]);}
  const float m=max2f(a,b);
  auto rr=__builtin_amdgcn_permlane32_swap(__float_as_uint(m),__float_as_uint(m),false,false);
  return max2f(__uint_as_float(rr[0]),__uint_as_float(rr[1]));
}
__device__ __forceinline__ void pv(f32x16*o,int vb,bf16x8 pa0,bf16x8 pa1,bf16x8 pa2,bf16x8 pa3){
  #pragma unroll
  for(int d0=0;d0<2;++d0){s16x4 lo[4],hi[4];
    #pragma unroll
    for(int ks=0;ks<4;++ks){
      asm volatile("ds_read_b64_tr_b16 %0,%1 offset:%c2":"=&v"(lo[ks]):"v"(vb),"i"(d0*4096+ks*1024):"memory");
      asm volatile("ds_read_b64_tr_b16 %0,%1 offset:%c2":"=&v"(hi[ks]):"v"(vb),"i"(d0*4096+ks*1024+512):"memory");}
    asm volatile("s_waitcnt lgkmcnt(0)":::"memory");SBAR();
    #define PK(k) (bf16x8){lo[k][0],lo[k][1],lo[k][2],lo[k][3],hi[k][0],hi[k][1],hi[k][2],hi[k][3]}
    o[d0]=__builtin_amdgcn_mfma_f32_32x32x16_bf16(pa0,PK(0),o[d0],0,0,0);
    o[d0]=__builtin_amdgcn_mfma_f32_32x32x16_bf16(pa1,PK(1),o[d0],0,0,0);
    o[d0]=__builtin_amdgcn_mfma_f32_32x32x16_bf16(pa2,PK(2),o[d0],0,0,0);
    o[d0]=__builtin_amdgcn_mfma_f32_32x32x16_bf16(pa3,PK(3),o[d0],0,0,0);
    #undef PK
  }
}

#ifndef ATTN_STORE16
#define ATTN_STORE16(p,v) (*(u32x4*)(p)=(v))
#endif
template<int THRL> __device__ __forceinline__ void attn_unit(int b,int h,int qb,const bf16*Q,const bf16*__restrict__ K,const bf16*__restrict__ V,bf16*O,const float*__restrict__ cneg,char*shm,const int wid,const float thr2){
  int lane=__builtin_amdgcn_mbcnt_hi(~0u,__builtin_amdgcn_mbcnt_lo(~0u,0u)); asm volatile("":"+v"(lane)); const int tid=wid*64+lane,r32=lane&31,hi=lane>>5;
  const long rowbase=(long)b*SEQ; const int q0=qb*QB;
  const bf16*Qw=Q+(rowbase+q0+wid*QBLK)*DM+h*D;
  const float*cgrow=cneg+((long)(b*NHEAD+h)*SEQ);
  int jstart; { const int NT0=(q0+QB)/KVBLK; const float cq=cgrow[q0], ce=cgrow[64*lane+63]; const bool sk=(lane<NT0-4)&&(cq-ce>thr2); jstart=((int)__builtin_popcountll(__ballot(sk)))&~1; }
  const bf16*Kh=K+(rowbase+(long)jstart*KVBLK)*DM+h*D,*Vh=V+(rowbase+(long)jstart*KVBLK)*DM+h*D;
  const unsigned lds0=(unsigned)(uintptr_t)shm;
  float*wsf=(float*)(shm+LDS_WS)+wid*64;
  const bf16*ksrc=Kh+(long)lane*DM+wid*8;
  const bf16*vsrc=Vh+(long)(16*(wid&3)+(lane>>2))*DM+(wid>>2)*32+(lane&3)*8;
  const unsigned kdst=lds0+LDS_K+wid*1024, vdst=lds0+LDS_V+wid*1024;
  #define DMA_K(t,slot) glds16(ksrc+(long)(t)*KVBLK*DM,(unsigned)__builtin_amdgcn_readfirstlane(kdst+(slot)))
  #define DMA_V(t,slot) glds16(vsrc+(long)(t)*KVBLK*DM,(unsigned)__builtin_amdgcn_readfirstlane(vdst+(slot)))
  const int vb0=(int)(lds0+LDS_V)+((lane>>4)&1)*32+(lane&3)*8+(4*hi+((lane&15)>>2))*64;
  const char*Kbase=shm+LDS_K; bf16x8 kf[8];
  const lds_cptr shm3=(lds_cptr)shm; const lds_cptr kp0=shm3+LDS_K+hi*1024+r32*16; const lds_cptr vp0=shm3+LDS_V+((lane>>4)&1)*32+(lane&3)*8+(4*hi+((lane&15)>>2))*64;
  const int NT=(q0+QB)/KVBLK-jstart;
  typedef __attribute__((address_space(3))) float lds_f32; typedef float f32x4b __attribute__((ext_vector_type(4)));
  lds_f32*const biasa=(lds_f32*)(shm3+LDS_BIAS);
  lds_f32*const biasl=biasa+64*jstart;
  { const f32x4b*cg4=(const f32x4b*)cgrow; const int n4=(q0+QB)>>2, s4=16*jstart;
    if(tid>=s4&&tid<n4)*(__attribute__((address_space(3))) f32x4b*)(biasa+4*tid)=cg4[tid];
    if(tid+512>=s4&&tid+512<n4)*(__attribute__((address_space(3))) f32x4b*)(biasa+4*(tid+512))=cg4[tid+512]; }
  #define BIASC(C0_,C1_,t_) do{ const lds_f32*bp_=biasl+64*(t_)+4*hi; \
    _Pragma("unroll") for(int g_=0;g_<4;++g_){ const f32x4b b0_=*(const __attribute__((address_space(3))) f32x4b*)(bp_+8*g_); const f32x4b b1_=*(const __attribute__((address_space(3))) f32x4b*)(bp_+32+8*g_); \
      _Pragma("unroll") for(int e_=0;e_<4;++e_){ C0_[4*g_+e_]=b0_[e_]-mhat; C1_[4*g_+e_]=b1_[e_]-mhat; } } }while(0)
  DMA_K(0,0);DMA_V(0,0);DMA_K(1,SLOTB);
  bf16x8 qr[4];
  #pragma unroll
  for(int d0=0;d0<4;++d0)qr[d0]=*reinterpret_cast<const bf16x8*>(&Qw[(long)r32*DM+d0*16+hi*8]);
  float mhat=0.f,l_reg=0.f;f32x16 o[2];o[0]=f32x16{};o[1]=f32x16{};
  const int qrel=wid*QBLK+r32;
  #define CMASK(P0,P1,t) do{int jb_=(t)-(NT-4); if(jb_>=0)cmask(P0,P1,jb_,qrel,hi);}while(0)
  bool resc=false;
  #define START(P0,P1) do{ const float rm=rowmax(P0,P1); resc=false; \
    { const float dl=rm; mhat=fadd_s(mhat,dl); \
      _Pragma("unroll") for(int r=0;r<16;++r){P0[r]=fsub_s(P0[r],dl);P1[r]=fsub_s(P1[r],dl);} \
      } \
    _Pragma("unroll") for(int r=0;r<16;++r)P0[r]=__builtin_amdgcn_exp2f(P0[r]); }while(0)
  #define RESC() do{ if(resc){ asm volatile("s_waitcnt lgkmcnt(0)":::"memory"); \
      _Pragma("unroll") for(int d_=0;d_<2;++d_) _Pragma("unroll") for(int r=0;r<16;++r)o[d_][r]*=wsf[crow(r,hi)]; } }while(0)
  f32x16 pA0,pA1,pB0,pB1;
  int sl_prev=0,sl_cur=0,sl_next=SLOTB;
  #define ROT() do{sl_prev=sl_cur;sl_cur=sl_next;sl_next=(sl_next==(NSLOT-1)*SLOTB)?0:sl_next+SLOTB;}while(0)
  DMA_K(2,2*SLOTB);
  WAIT_BAR(3);
  BIASC(pA0,pA1,0); qkt(pA0,pA1,Kbase,qr,r32,hi);asm volatile("s_nop 15\n\ts_nop 7":"+v"(pA0),"+v"(pA1));CMASK(pA0,pA1,0);
  START(pA0,pA1);
  _Pragma("unroll") for(int r=0;r<16;++r)pA1[r]=__builtin_amdgcn_exp2f(pA1[r]);
  WAIT_BAR(0);
  DMA_K(3,0);DMA_V(1,SLOTB);
  ROT();
  kload8(kf,kp0+sl_cur);
  WAIT_BAR(2);
  s16x4 vlo[8],vhi[8]; u32x4 pw0,pw1,pw2,pw3;
  #define PKW(P,B) cvtpk_s(P[B],P[B+1])
  #define PAF(k) __builtin_bit_cast(bf16x8,pw##k)
  #define VFR(i) (bf16x8){vlo[i][0],vlo[i][1],vlo[i][2],vlo[i][3],vhi[i][0],vhi[i][1],vhi[i][2],vhi[i][3]}
  #define PIN(x) asm volatile("":"+v"(x))
  #define MX3(a,b,c) __builtin_fmaxf(__builtin_fmaxf((a),(b)),(c))
  #define GAPA(MF,A0,A1,A2,A3,W0,W1,PW) do{ MF; sacc+=A0; sacc+=A1; sacc+=A2; sacc+=A3; PIN(sacc); W0; W1; PIN(PW); SBAR(); }while(0)
  #define EX(v) __builtin_amdgcn_exp2f(v)
  #define GAPB(MF,X,B) do{ MF; X[B]=EX(X[B]); X[B+1]=EX(X[B+1]); X[B+2]=EX(X[B+2]); X[B+3]=EX(X[B+3]); PIN(X); SBAR(); }while(0)
  #define VRD(i) do{ vlo[i]=vtr(vp_+(((i)>>2)*4096+((i)&3)*1024)); vhi[i]=vtr(vp_+(((i)>>2)*4096+((i)&3)*1024+512)); }while(0)
  #define KRD(G,j) do{ if(G){ kload2(kf,kp0+sl_next,j); SBAR(); } }while(0)
  #define STEP(C0,C1,P0,P1,t,GK,GV,GL,GB) do{ SBAR(); \
    const lds_cptr vp_=vp0+sl_prev; \
    VRD(0); SBAR(); float sacc=(P0[0]+P0[1]); \
    GAPA(C0=__builtin_amdgcn_mfma_f32_32x32x16_bf16(kf[0],qr[0],C0,0,0,0), P0[2],P0[3],P0[4],P0[5],     pw0[0]=PKW(P0,0), pw0[1]=PKW(P0,2), pw0); \
    VRD(4); SBAR(); GAPA(C1=__builtin_amdgcn_mfma_f32_32x32x16_bf16(kf[1],qr[0],C1,0,0,0), P0[6],P0[7],P0[8],P0[9],     pw0[2]=PKW(P0,4), pw0[3]=PKW(P0,6), pw0); \
    VRD(1); SBAR(); GAPA(C0=__builtin_amdgcn_mfma_f32_32x32x16_bf16(kf[2],qr[1],C0,0,0,0),   P0[10],P0[11],P0[12],P0[13], pw1[0]=PKW(P0,8), pw1[1]=PKW(P0,10), pw1); \
    VRD(5); SBAR(); GAPA(C1=__builtin_amdgcn_mfma_f32_32x32x16_bf16(kf[3],qr[1],C1,0,0,0),   P0[14],P0[15],P1[0],P1[1],   pw1[2]=PKW(P0,12),pw1[3]=PKW(P0,14), pw1); \
    VRD(2); SBAR(); GAPA(C0=__builtin_amdgcn_mfma_f32_32x32x16_bf16(kf[4],qr[2],C0,0,0,0),   P1[2],P1[3],P1[4],P1[5],     pw2[0]=PKW(P1,0), pw2[1]=PKW(P1,2), pw2); \
    VRD(6); SBAR(); GAPA(C1=__builtin_amdgcn_mfma_f32_32x32x16_bf16(kf[5],qr[2],C1,0,0,0),   P1[6],P1[7],P1[8],P1[9],     pw2[2]=PKW(P1,4), pw2[3]=PKW(P1,6), pw2); \
    VRD(3); SBAR(); GAPA(C0=__builtin_amdgcn_mfma_f32_32x32x16_bf16(kf[6],qr[3],C0,0,0,0),   P1[10],P1[11],P1[12],P1[13], pw3[0]=PKW(P1,8), pw3[1]=PKW(P1,10), pw3); \
    VRD(7); SBAR(); GAPA(C1=__builtin_amdgcn_mfma_f32_32x32x16_bf16(kf[7],qr[3],C1,0,0,0),   P1[14],P1[15],0.f,0.f,       pw3[2]=PKW(P1,12),pw3[3]=PKW(P1,14), pw3); \
    l_reg+=sacc; \
    if(GK){DMA_K((t)+3,sl_cur);} if(GV){DMA_V((t)+1,sl_next);} \
    CMASK(C0,C1,t); \
    { float a=MX3(C0[0],C0[1],C1[0]),b=MX3(C0[2],C0[3],C1[1]); a=MX3(a,C1[2],C1[3]); \
      _Pragma("unroll") for(int r=4;r<16;r+=4){a=MX3(a,C0[r],C0[r+1]);b=MX3(b,C0[r+2],C0[r+3]);a=MX3(a,C1[r],C1[r+1]);b=MX3(b,C1[r+2],C1[r+3]);} \
      float rm=__builtin_fmaxf(a,b); { auto rr=__builtin_amdgcn_permlane32_swap(__float_as_uint(rm),__float_as_uint(rm),false,false); rm=__builtin_fmaxf(__uint_as_float(rr[0]),__uint_as_float(rr[1])); } \
      resc=false; \
      if(__builtin_expect(__any(rm>(float)THRL),0)){ const float dl=__builtin_fmaxf(rm,0.f); mhat+=dl; \
        _Pragma("unroll") for(int r=0;r<16;++r){C0[r]-=dl;C1[r]-=dl;} \
        const float f=__builtin_amdgcn_exp2f(-dl); l_reg*=f; if(hi==0)wsf[r32]=f; resc=true; } } \
    SBAR(); \
    GAPB(o[0]=__builtin_amdgcn_mfma_f32_32x32x16_bf16(PAF(0),VFR(0),o[0],0,0,0), C0,0); \
    GAPB(o[1]=__builtin_amdgcn_mfma_f32_32x32x16_bf16(PAF(0),VFR(4),o[1],0,0,0), C0,4); \
    KRD(GL,0); GAPB(o[0]=__builtin_amdgcn_mfma_f32_32x32x16_bf16(PAF(1),VFR(1),o[0],0,0,0), C0,8); \
    KRD(GL,1); GAPB(o[1]=__builtin_amdgcn_mfma_f32_32x32x16_bf16(PAF(1),VFR(5),o[1],0,0,0), C0,12); \
    KRD(GL,2); GAPB(o[0]=__builtin_amdgcn_mfma_f32_32x32x16_bf16(PAF(2),VFR(2),o[0],0,0,0), C1,0); \
    KRD(GL,3); GAPB(o[1]=__builtin_amdgcn_mfma_f32_32x32x16_bf16(PAF(2),VFR(6),o[1],0,0,0), C1,4); \
    GAPB(o[0]=__builtin_amdgcn_mfma_f32_32x32x16_bf16(PAF(3),VFR(3),o[0],0,0,0), C1,8); \
    GAPB(o[1]=__builtin_amdgcn_mfma_f32_32x32x16_bf16(PAF(3),VFR(7),o[1],0,0,0), C1,12); \
    if(GB){ BIASC(P0,P1,(t)+1); SBAR(); } \
    }while(0)
  int t=1;
  BIASC(pB0,pB1,1); SBAR();
  #undef CMASK
  #define CMASK(P0,P1,t) do{}while(0)
  for(;t+5<NT;t+=2){
    STEP(pB0,pB1,pA0,pA1,t,true,true,true,true);     WAIT_BAR(2); RESC(); ROT();
    STEP(pA0,pA1,pB0,pB1,t+1,true,true,true,true);   WAIT_BAR(2); RESC(); ROT();
  }
  #undef CMASK
  #define CMASK(P0,P1,t) do{int jb_=(t)-(NT-4); if(jb_>=0)cmask(P0,P1,jb_,qrel,hi);}while(0)
  #define ENDW(tt) do{ if((tt)+3<NT){WAIT_BAR(2);} else if((tt)+2<NT){WAIT_BAR(1);} else {WAIT_BAR(0);} }while(0)
  for(;t+1<NT;t+=2){
    STEP(pB0,pB1,pA0,pA1,t,(t+3<NT),(t+1<NT),(t+1<NT),true);       ENDW(t);   RESC(); ROT();
    STEP(pA0,pA1,pB0,pB1,t+1,(t+4<NT),(t+2<NT),(t+2<NT),true);     ENDW(t+1); RESC(); ROT();
  }
  STEP(pB0,pB1,pA0,pA1,NT-1,false,false,false,false); RESC();
  { float sacc=pB0[0]+pB0[1]; _Pragma("unroll") for(int r=2;r<16;++r)sacc+=pB0[r]; _Pragma("unroll") for(int r=0;r<16;++r)sacc+=pB1[r]; l_reg+=sacc;
    pw0=(u32x4){PKW(pB0,0),PKW(pB0,2),PKW(pB0,4),PKW(pB0,6)};pw1=(u32x4){PKW(pB0,8),PKW(pB0,10),PKW(pB0,12),PKW(pB0,14)};pw2=(u32x4){PKW(pB1,0),PKW(pB1,2),PKW(pB1,4),PKW(pB1,6)};pw3=(u32x4){PKW(pB1,8),PKW(pB1,10),PKW(pB1,12),PKW(pB1,14)};
    SBAR(); pv(o,vb0+sl_cur,PAF(0),PAF(1),PAF(2),PAF(3)); }
  #undef PKW
  #undef PAF
  #undef VFR
  #undef PIN
  #undef MX3
  #undef GAPA
  #undef GAPB
  #undef EX
  #undef VRD
  #undef KRD
  #undef STEP
  #undef ENDW
  {auto rr=__builtin_amdgcn_permlane32_swap(__float_as_uint(l_reg),__float_as_uint(l_reg),false,false);l_reg=__uint_as_float(rr[0])+__uint_as_float(rr[1]);}
  if(hi==0)wsf[32+r32]=l_reg;asm volatile("s_waitcnt lgkmcnt(0)":::"memory");
  float rli[16];
  #pragma unroll
  for(int r=0;r<16;++r)rli[r]=__builtin_amdgcn_rcpf(wsf[32+crow(r,hi)]);
  bf16*Ow=O+(rowbase+q0+wid*QBLK)*DM+h*D;
  { bf16*stg=(bf16*)(shm+LDS_OST)+wid*2048;
    #pragma unroll
    for(int r=0;r<16;++r){const int orow=crow(r,hi);
      #pragma unroll
      for(int d0=0;d0<2;++d0)stg[orow*64+d0*32+r32]=__float2bfloat16(o[d0][r]*rli[r]);}
    asm volatile("s_waitcnt lgkmcnt(0)":::"memory");
    #pragma unroll
    for(int i=0;i<4;++i){const int row=i*8+(lane>>3),ch=lane&7; const u32x4 v=*(const u32x4*)(stg+row*64+ch*8); ATTN_STORE16(Ow+(long)row*DM+ch*8,v);} }
  asm volatile("s_waitcnt lgkmcnt(0)\n\ts_barrier":::"memory");
  #undef DMA_K
  #undef DMA_V
  #undef CMASK
  #undef START
  #undef RESC
  #undef ROT
  #undef BIASC
}
constexpr int ATTN_LDS_BYTES=LDS_BYTES;
#undef SBAR
#undef WAIT_BAR
}

#define LAS __attribute__((address_space(3)))
typedef unsigned short bf16;
typedef float f32x4 __attribute__((ext_vector_type(4)));
typedef unsigned v4u __attribute__((ext_vector_type(4)));
#define LDS_WAIT() asm volatile("s_waitcnt lgkmcnt(0)" ::: "memory")

constexpr int BATCH = 16, SEQ = 4096, DM = 1024, M = BATCH * SEQ, INW = 5648, FF = 2816;
constexpr int N1 = 5632, NGU = 5632;
constexpr float EPS = 1e-6f;
constexpr float LOG2E = 1.4426950408889634f, C2 = 0.125f * LOG2E;
constexpr int LDS_BYTES = 155648;
#ifndef PHMASK
#define PHMASK 255
#endif
constexpr int PH = PHMASK;
#ifndef P2REP
#define P2REP 1
#endif
#ifndef MLREP
#define MLREP 1
#endif

constexpr size_t MiB = (size_t)1 << 20;
constexpr size_t WS_BT1 = 0, WS_BTGU = 11 * MiB, WS_BTD = 22 * MiB, WS_BTO = 55 * MiB / 2, WS_BTFO = 59 * MiB / 2, WS_BTMO = 61 * MiB / 2;
constexpr size_t WS_XB = 32 * MiB, WS_MERGED = WS_XB;
constexpr size_t WS_QF = 160 * MiB, WS_KF = 224 * MiB, WS_VF = 288 * MiB, WS_MQ = 352 * MiB, WS_MK = 416 * MiB, WS_MV = 480 * MiB, WS_SOB = 544 * MiB;
constexpr size_t WS_HMID = 160 * MiB;
constexpr size_t WS_SGA = 608 * MiB, WS_SGB = 736 * MiB, WS_X1B = WS_SGA;
constexpr size_t WS_YA = 864 * MiB, WS_YB = 928 * MiB;
constexpr size_t WS_SM = 992 * MiB;
constexpr size_t WS_RSTD1 = WS_SM, WS_LFA = WS_SM + 1 * MiB, WS_LI = WS_SM + 3 * MiB, WS_LFB = WS_SM + 4 * MiB, WS_CNEG = WS_SM + 5 * MiB, WS_SSP = WS_SM + 8 * MiB, WS_CTL = WS_SM + 12 * MiB;
constexpr size_t WS_END = 1024 * MiB;

__device__ __forceinline__ unsigned f2bf(float f) { unsigned u = __builtin_bit_cast(unsigned, f); return (u + 0x7fffu + ((u >> 16) & 1u)) >> 16; }
__device__ __forceinline__ unsigned pk2(float lo, float hi) { return f2bf(lo) | (f2bf(hi) << 16); }
__device__ __forceinline__ float bf2f(bf16 b) { return __builtin_bit_cast(float, (unsigned)b << 16); }
__device__ __forceinline__ float bflo(unsigned w) { return __builtin_bit_cast(float, w << 16); }
__device__ __forceinline__ float bfhi(unsigned w) { return __builtin_bit_cast(float, w & 0xffff0000u); }
__device__ __forceinline__ float wave_sum(float v) {
#pragma unroll
    for (int o = 1; o < 64; o <<= 1) v += __shfl_xor(v, o);
    return v;
}
__device__ __forceinline__ float sigmoidf_(float x) { return __builtin_amdgcn_rcpf(1.0f + __expf(-x)); }
__device__ __forceinline__ float logsigf_(float z) { return fminf(z, 0.f) - log1pf(expf(-fabsf(z))); }
__device__ __forceinline__ v4u pack8(f32x4 a, f32x4 b) { v4u w; w.x = pg8::cvt_pk_bf16(a[0], a[1]); w.y = pg8::cvt_pk_bf16(a[2], a[3]); w.z = pg8::cvt_pk_bf16(b[0], b[1]); w.w = pg8::cvt_pk_bf16(b[2], b[3]); return w; }
__device__ __forceinline__ float dot4(f32x4 a, f32x4 b) { return (a[0] * b[0] + a[1] * b[1]) + (a[2] * b[2] + a[3] * b[3]); }

struct Args { const float* in[18]; float* out; unsigned char* ws; };
typedef const __attribute__((address_space(4))) Args* KArgs;
__device__ __forceinline__ KArgs kargs() { KArgs p = (KArgs)__builtin_amdgcn_kernarg_segment_ptr(); asm volatile("" : "+s"(p)); return p; }

constexpr size_t WS_BAR = WS_CTL + 65536;
#define XB_TMO      128
#define XB_XCNT(j)  (256  + 64 * (j))
#define XB_XSUB(j)  (1280 + 64 * (j))
#define XB_XGEN(j)  (2304 + 64 * (j))
#define XB_TOP      3328
#define XB_TOPGEN   3392
#define XCD_BAR_WORDS 3456
#define XB_SPIN_CAP (1u << 18)

__device__ __forceinline__ unsigned xb_ld(unsigned* p)              { return __hip_atomic_load(p, __ATOMIC_RELAXED, __HIP_MEMORY_SCOPE_AGENT); }
__device__ __forceinline__ unsigned xb_add(unsigned* p, unsigned v) { return __hip_atomic_fetch_add(p, v, __ATOMIC_RELAXED, __HIP_MEMORY_SCOPE_AGENT); }
__device__ __forceinline__ unsigned xb_xcc_id() { return (unsigned)__builtin_amdgcn_s_getreg((3 << 11) | 20) & 0xFu; }
#define XB_SPIN(cond, bar) do { unsigned _sp = 0; while (cond) { __builtin_amdgcn_s_sleep(1); \
    if ((++_sp & 255u) == 0u) { if (xb_ld(&(bar)[XB_TMO])) break; if (_sp > XB_SPIN_CAP) { atomicAdd(&(bar)[XB_TMO], 1u); break; } } } } while (0)

struct XcdBarrier {
    unsigned* bar; unsigned x;
    volatile LAS unsigned* st;
};

__device__ __forceinline__ XcdBarrier xcd_barrier_post(unsigned* bar, volatile LAS unsigned* st) {
    XcdBarrier b; b.bar = bar; b.x = xb_xcc_id(); b.st = st;
    if (threadIdx.x == 0) (void)xb_add(&bar[XB_XCNT(b.x)], 1u);
    return b;
}
__device__ __forceinline__ void xcd_barrier_complete(unsigned* bar, unsigned x, unsigned& nloc, unsigned& nx) {
    const unsigned G = gridDim.x * gridDim.y * gridDim.z;
    unsigned sum, cnt, mine, sp = 0u;
    for (;;) {
        sum = 0u; cnt = 0u; mine = 0u;
#pragma unroll
        for (unsigned j = 0; j < 16; ++j) { const unsigned c = xb_ld(&bar[XB_XCNT(j)]); sum += c; cnt += (c > 0u) ? 1u : 0u; mine = (j == x) ? c : mine; }
        if (sum == G) break;
        __builtin_amdgcn_s_sleep(1);
        if ((++sp & 255u) == 0u) { if (xb_ld(&bar[XB_TMO])) break; if (sp > XB_SPIN_CAP) { atomicAdd(&bar[XB_TMO], 1u); break; } }
    }
    nloc = mine > 0u ? mine : 1u; nx = cnt > 0u ? cnt : 1u;
}

__device__ __forceinline__ void xcd_barrier(const XcdBarrier& b) {
    asm volatile("s_waitcnt vmcnt(0)" ::: "memory");
    __syncthreads();
    if (threadIdx.x == 0) {
        unsigned* bar = b.bar;
        __builtin_amdgcn_s_waitcnt(0);
        unsigned nloc = b.st[0], nx = b.st[1];
        if (nloc == 0u) { xcd_barrier_complete(bar, b.x, nloc, nx); b.st[0] = nloc; b.st[1] = nx; }
        const unsigned old = xb_add(&bar[XB_XSUB(b.x)], 1u);
        const unsigned gen = old / nloc;
        if (old + 1u == (gen + 1u) * nloc) {
            __builtin_amdgcn_fence(__ATOMIC_RELEASE, "agent");
            asm volatile("s_waitcnt vmcnt(0)" ::: "memory");
            const unsigned og = xb_add(&bar[XB_TOP], 1u);
            const unsigned tg = og / nx;
            if (og + 1u == (tg + 1u) * nx) xb_add(&bar[XB_TOPGEN], 1u);
            else XB_SPIN(xb_ld(&bar[XB_TOPGEN]) == tg, bar);
            __builtin_amdgcn_fence(__ATOMIC_ACQUIRE, "agent");
            xb_add(&bar[XB_XGEN(b.x)], 1u);
            asm volatile("s_waitcnt vmcnt(0)" ::: "memory");
        } else {
            XB_SPIN(xb_ld(&bar[XB_XGEN(b.x)]) == gen, bar);
            __builtin_amdgcn_fence(__ATOMIC_ACQUIRE, "agent");
            asm volatile("s_waitcnt vmcnt(0)" ::: "memory");
        }
    }
    __syncthreads();
}

struct Epi1 {
    static constexpr bool PERM = true, AFTER_DRAIN = false;
    const LAS float* rsl; int g0;     bf16* qf; bf16* kf; bf16* vf5; bf16* sg2; const float* gq; const float* gk; int pn_off;
    __device__ __forceinline__ void operator()(const f32x4 (&acc)[2][2][4][2], const pg8::Unit& u, int wr, int wc, int fr, int fq) const {
        const int pn = u.pn + pn_off; const int row0 = u.pm * 256 + wr * 64 + fr;
        const LAS float* rsb = rsl + ((u.pm >> 3) - g0) * 256 + wr * 64 + fr;
        if (pn < 4) {
            bf16* O = pn < 2 ? qf : kf; const float* g = pn < 2 ? gq : gk; const float post = pn < 2 ? C2 : 1.f;
            const int head = 4 * (pn & 1) + wc;
            f32x4 gv[2][2];
#pragma unroll
            for (int bj = 0; bj < 2; ++bj)
#pragma unroll
                for (int n = 0; n < 2; ++n) gv[bj][n] = *(const f32x4*)(g + 32 * bj + 8 * fq + 4 * n);
#pragma unroll
            for (int ai = 0; ai < 2; ++ai)
#pragma unroll
                for (int m = 0; m < 4; ++m) {
                    const int row = row0 + ai * 128 + m * 16; const float rs = rsb[ai * 128 + m * 16];
                    f32x4 v[2][2]; float ss = 0.f;
#pragma unroll
                    for (int bj = 0; bj < 2; ++bj)
#pragma unroll
                        for (int n = 0; n < 2; ++n) { v[bj][n] = acc[ai][bj][m][n] * rs; ss += dot4(v[bj][n], v[bj][n]); }
                    ss += __shfl_xor(ss, 16); ss += __shfl_xor(ss, 32);
                    const float r = post * __builtin_amdgcn_rsqf(ss * (1.0f / 64.0f) + EPS);
#pragma unroll
                    for (int bj = 0; bj < 2; ++bj) {
                        const f32x4 a = v[bj][0] * gv[bj][0] * r, b = v[bj][1] * gv[bj][1] * r;
                        *(v4u*)(O + (size_t)row * 512 + head * 64 + 32 * bj + 8 * fq) = pack8(a, b);
                    }
                }
        } else if (pn < 6 || pn >= 14) {
            const int s = pn < 6 ? pn - 4 : pn - 12; bf16* O = vf5 + (size_t)(s >> 1) * ((size_t)M * 512); const int col0 = (s & 1) * 256 + wc * 32 + 8 * fq; const bool sig = pn >= 20;
#pragma unroll
            for (int ai = 0; ai < 2; ++ai)
#pragma unroll
                for (int m = 0; m < 4; ++m) {
                    const int row = row0 + ai * 128 + m * 16; const float rs = rsb[ai * 128 + m * 16];
#pragma unroll
                    for (int bj = 0; bj < 2; ++bj) {
                        f32x4 a = acc[ai][bj][m][0] * rs, b = acc[ai][bj][m][1] * rs;
                        if (sig) {
#pragma unroll
                            for (int e = 0; e < 4; ++e) { a[e] = sigmoidf_(a[e]); b[e] = sigmoidf_(b[e]); }
                        }
                        *(v4u*)(O + (size_t)row * 512 + col0 + bj * 128) = pack8(a, b);
                    }
                }
        } else {
            const int s = pn - 6; bf16* O = sg2 + (size_t)(s >> 2) * ((size_t)M * 1024); const int col0 = (s & 3) * 256 + wc * 32 + 8 * fq;
#pragma unroll
            for (int ai = 0; ai < 2; ++ai)
#pragma unroll
                for (int m = 0; m < 4; ++m) {
                    const int row = row0 + ai * 128 + m * 16; const float rs = rsb[ai * 128 + m * 16];
#pragma unroll
                    for (int bj = 0; bj < 2; ++bj) {
                        f32x4 a = acc[ai][bj][m][0] * rs, b = acc[ai][bj][m][1] * rs;
#pragma unroll
                        for (int e = 0; e < 4; ++e) { a[e] = sigmoidf_(a[e]); b[e] = sigmoidf_(b[e]); }
                        *(v4u*)(O + (size_t)row * 1024 + col0 + bj * 128) = pack8(a, b);
                    }
                }
        }
    }
};

template <int PASS> struct EpiGate {
    static constexpr bool PERM = true, AFTER_DRAIN = false;
    const bf16* sg; bf16* mg;
    __device__ __forceinline__ void operator()(const f32x4 (&acc)[2][2][4][2], const pg8::Unit& u, int wr, int wc, int fr, int fq) const {
        const int row0 = u.pm * 256 + wr * 64 + fr; const int col0 = u.pn * 256 + wc * 32 + 8 * fq;
#pragma unroll
        for (int ai = 0; ai < 2; ++ai) {
            v4u gv[4][2], pv[4][2];
#pragma unroll
            for (int m = 0; m < 4; ++m)
#pragma unroll
                for (int bj = 0; bj < 2; ++bj) { const size_t off = (size_t)(row0 + ai * 128 + m * 16) * 1024 + col0 + bj * 128; gv[m][bj] = *(const v4u*)(sg + off); if (PASS == 1) pv[m][bj] = *(const v4u*)(mg + off); }
            asm volatile("" ::: "memory");
#pragma unroll
            for (int m = 0; m < 4; ++m)
#pragma unroll
                for (int bj = 0; bj < 2; ++bj) {
                    const size_t off = (size_t)(row0 + ai * 128 + m * 16) * 1024 + col0 + bj * 128;
                    const v4u g = gv[m][bj];
                    f32x4 a = acc[ai][bj][m][0], b = acc[ai][bj][m][1];
                    a[0] *= bflo(g.x); a[1] *= bfhi(g.x); a[2] *= bflo(g.y); a[3] *= bfhi(g.y);
                    b[0] *= bflo(g.z); b[1] *= bfhi(g.z); b[2] *= bflo(g.w); b[3] *= bfhi(g.w);
                    if (PASS == 1) {
                        const v4u p = pv[m][bj];
                        a[0] += bflo(p.x); a[1] += bfhi(p.x); a[2] += bflo(p.y); a[3] += bfhi(p.y);
                        b[0] += bflo(p.z); b[1] += bfhi(p.z); b[2] += bflo(p.w); b[3] += bfhi(p.w);
                    }
                    *(v4u*)(mg + off) = pack8(a, b);
                }
        }
    }
};

struct EpiX1 {
    static constexpr bool PERM = true, AFTER_DRAIN = false;
    const bf16* xb; bf16* x1b; float* ssp;
    __device__ __forceinline__ void operator()(const f32x4 (&acc)[2][2][4][2], const pg8::Unit& u, int wr, int wc, int fr, int fq) const {
        const int row0 = u.pm * 256 + wr * 64 + fr; const int col0 = u.pn * 256 + wc * 32 + 8 * fq;
        v4u xv[2][4][2];
#pragma unroll
        for (int ai = 0; ai < 2; ++ai)
#pragma unroll
            for (int m = 0; m < 4; ++m)
#pragma unroll
                for (int bj = 0; bj < 2; ++bj) xv[ai][m][bj] = *(const v4u*)(xb + (size_t)(row0 + ai * 128 + m * 16) * 1024 + col0 + bj * 128);
        asm volatile("" ::: "memory");
#pragma unroll
        for (int ai = 0; ai < 2; ++ai)
#pragma unroll
            for (int m = 0; m < 4; ++m) {
                const int row = row0 + ai * 128 + m * 16; float ss = 0.f;
#pragma unroll
                for (int bj = 0; bj < 2; ++bj) {
                    const size_t off = (size_t)row * 1024 + col0 + bj * 128; const v4u w = xv[ai][m][bj];
                    const f32x4 r0 = (f32x4){bflo(w.x), bfhi(w.x), bflo(w.y), bfhi(w.y)} + acc[ai][bj][m][0], r1 = (f32x4){bflo(w.z), bfhi(w.z), bflo(w.w), bfhi(w.w)} + acc[ai][bj][m][1];
                    ss += dot4(r0, r0) + dot4(r1, r1);
                    *(v4u*)(x1b + off) = pack8(r0, r1);
                }
                ss += __shfl_xor(ss, 16); ss += __shfl_xor(ss, 32);
                if (fq == 0) ssp[(size_t)row * 16 + u.pn * 4 + wc] = ss;
            }
    }
};

struct EpiFFN {
    static constexpr bool PERM = true, AFTER_DRAIN = false;
    const LAS float* rsl; int g0; bf16* hmid;
    __device__ __forceinline__ void operator()(const f32x4 (&acc)[2][2][4][2], const pg8::Unit& u, int wr, int wc, int fr, int fq) const {
        const int row0 = u.pm * 256 + wr * 64 + fr; const int col0 = u.pn * 128 + wc * 32 + 8 * fq;
        const LAS float* rsb = rsl + ((u.pm >> 3) - g0) * 256 + wr * 64 + fr;
#pragma unroll
        for (int ai = 0; ai < 2; ++ai)
#pragma unroll
            for (int m = 0; m < 4; ++m) {
                const int row = row0 + ai * 128 + m * 16; const float rs = rsb[ai * 128 + m * 16];
                f32x4 h0, h1;
#pragma unroll
                for (int e = 0; e < 4; ++e) {
                    const float g0_ = acc[ai][0][m][0][e] * rs, u0 = acc[ai][1][m][0][e] * rs, g1 = acc[ai][0][m][1][e] * rs, u1 = acc[ai][1][m][1][e] * rs;
                    h0[e] = g0_ * sigmoidf_(g0_) * u0; h1[e] = g1 * sigmoidf_(g1) * u1;
                }
                *(v4u*)(hmid + (size_t)row * FF + col0) = pack8(h0, h1);
            }
    }
};

struct EpiOut {
    static constexpr bool PERM = true, AFTER_DRAIN = false;
    const bf16* x1b; float* out;
    __device__ __forceinline__ void operator()(const f32x4 (&acc)[2][2][4][2], const pg8::Unit& u, int wr, int wc, int fr, int fq) const {
        const int row0 = u.pm * 256 + wr * 64 + fr; const int col0 = u.pn * 256 + wc * 32 + 8 * fq;
        v4u xv[2][4][2];
#pragma unroll
        for (int ai = 0; ai < 2; ++ai)
#pragma unroll
            for (int m = 0; m < 4; ++m)
#pragma unroll
                for (int bj = 0; bj < 2; ++bj) xv[ai][m][bj] = *(const v4u*)(x1b + (size_t)(row0 + ai * 128 + m * 16) * 1024 + col0 + bj * 128);
        asm volatile("" ::: "memory");
#pragma unroll
        for (int ai = 0; ai < 2; ++ai)
#pragma unroll
            for (int m = 0; m < 4; ++m)
#pragma unroll
                for (int bj = 0; bj < 2; ++bj) {
                    const size_t off = (size_t)(row0 + ai * 128 + m * 16) * 1024 + col0 + bj * 128; const v4u w = xv[ai][m][bj];
                    *(f32x4*)(out + off) = (f32x4){bflo(w.x), bfhi(w.x), bflo(w.y), bfhi(w.y)} + acc[ai][bj][m][0];
                    *(f32x4*)(out + off + 4) = (f32x4){bflo(w.z), bfhi(w.z), bflo(w.w), bfhi(w.w)} + acc[ai][bj][m][1];
                }
    }
};

struct P0Item { const float* W; const float* gs; bf16* WT; int ldw, src, k0, Kd, drow; };
__device__ __forceinline__ void p0_item_issue(const P0Item& d, f32x4 (&wl)[8], float (&gv)[8], int lane) {
#pragma unroll
    for (int i = 0; i < 8; ++i) { const int kk = 8 * i + (lane >> 3); wl[i] = *(const f32x4*)(d.W + (size_t)(d.k0 + kk) * d.ldw + d.src + 4 * (lane & 7)); gv[i] = d.gs ? d.gs[d.k0 + kk] : 1.0f; }
}
__device__ __forceinline__ void p0_item_finish(const P0Item& d, const f32x4 (&wl)[8], const float (&gv)[8], LAS float* scr, int lane) {
#pragma unroll
    for (int i = 0; i < 8; ++i) { const int kk = 8 * i + (lane >> 3); const f32x4 w = wl[i] * gv[i];
        LAS float* q = scr + kk * 33 + 4 * (lane & 7); q[0] = w[0]; q[1] = w[1]; q[2] = w[2]; q[3] = w[3]; }
    LDS_WAIT(); asm volatile("" ::: "memory");
    const int c = lane & 7;
#pragma unroll
    for (int j = 0; j < 4; ++j) { const int n = (lane >> 3) + 8 * j; const LAS float* s = scr + (8 * c) * 33 + n;
        v4u o; o.x = pk2(s[0 * 33], s[1 * 33]); o.y = pk2(s[2 * 33], s[3 * 33]); o.z = pk2(s[4 * 33], s[5 * 33]); o.w = pk2(s[6 * 33], s[7 * 33]);
        *(v4u*)(d.WT + (size_t)(d.drow + n) * d.Kd + d.k0 + 8 * c) = o; }
    LDS_WAIT(); asm volatile("" ::: "memory");
}
__device__ __forceinline__ P0Item p0_decode(KArgs a, unsigned char* ws, int it) {
    constexpr int IT_1 = 16 * 176, IT_FO = 8 * 32, IT_MO = 8 * 32, IT_O = 16 * 32, IT_GU = 16 * 176;
    P0Item d; int r = it;
    if (r < IT_1) { const int kb = r / 176, grp = r % 176, pn = grp >> 3, g8 = grp & 7; int src;
        if (pn < 4) src = (pn < 2 ? 0 : 512) + (4 * (pn & 1) + (g8 & 3)) * 64 + 32 * (g8 >> 2);
        else if (pn < 6) src = 1024 + (pn - 4) * 256 + 32 * g8;
        else if (pn < 14) src = 3600 + (pn - 6) * 256 + 32 * g8;
        else if (pn < 20) src = 1544 + (pn - 14) * 256 + 32 * g8;
        else src = 3088 + (pn - 20) * 256 + 32 * g8;
        d.W = a->in[2]; d.gs = a->in[1]; d.WT = (bf16*)(ws + WS_BT1); d.ldw = INW; d.src = src; d.k0 = 64 * kb; d.Kd = 1024; d.drow = 32 * grp; return d; }
    r -= IT_1;
    if (r < IT_FO) { const int kb = r / 32, grp = r % 32; d.W = a->in[11]; d.gs = nullptr; d.WT = (bf16*)(ws + WS_BTFO); d.ldw = 1024; d.src = 32 * grp; d.k0 = 64 * kb; d.Kd = 512; d.drow = 32 * grp; return d; }
    r -= IT_FO;
    if (r < IT_MO) { const int kb = r / 32, grp = r % 32; d.W = a->in[12]; d.gs = nullptr; d.WT = (bf16*)(ws + WS_BTMO); d.ldw = 1024; d.src = 32 * grp; d.k0 = 64 * kb; d.Kd = 512; d.drow = 32 * grp; return d; }
    r -= IT_MO;
    if (r < IT_O) { const int kb = r / 32, grp = r % 32; d.W = a->in[13]; d.gs = nullptr; d.WT = (bf16*)(ws + WS_BTO); d.ldw = 1024; d.src = 32 * grp; d.k0 = 64 * kb; d.Kd = 1024; d.drow = 32 * grp; return d; }
    r -= IT_O;
    if (r < IT_GU) { const int kb = r / 176, grp = r % 176, pn = grp >> 3, g8 = grp & 7;
        d.W = g8 < 4 ? a->in[15] : a->in[16]; d.gs = a->in[14]; d.WT = (bf16*)(ws + WS_BTGU); d.ldw = FF; d.src = 128 * pn + 32 * (g8 & 3); d.k0 = 64 * kb; d.Kd = 1024; d.drow = 32 * grp; return d; }
    r -= IT_GU;
    { const int kb = r / 32, grp = r % 32; d.W = a->in[17]; d.gs = nullptr; d.WT = (bf16*)(ws + WS_BTD); d.ldw = 1024; d.src = 32 * grp; d.k0 = 64 * kb; d.Kd = FF; d.drow = 32 * grp; }
    return d;
}

__device__ __forceinline__ void p0_phase(KArgs a, LAS unsigned char* lds, int tid, int lane, int wave) {
    unsigned char* ws = a->ws;
    const float* x = a->in[0]; const float* g_mix = a->in[1]; const float* w_in = a->in[2];
    const int G = gridDim.x, gw = blockIdx.x * 8 + wave, NGW = G * 8;
    LAS float* scr = (LAS float*)(lds + wave * 8704);
    LAS float* wgs = (LAS float*)(lds + 69632);
    if (blockIdx.x == 0 && tid < 8) ((unsigned*)(ws + WS_CTL))[64 * tid] = 0u;
    if (blockIdx.x == 0) for (int i = tid; i < XCD_BAR_WORDS; i += 512) ((unsigned*)(ws + WS_BAR))[i] = 0u;
    if (blockIdx.x == 0 && wave == 1) {
        float gq = fabsf(a->in[4][lane]), gk = fabsf(a->in[5][lane]);
#pragma unroll
        for (int o = 1; o < 64; o <<= 1) { gq = fmaxf(gq, __shfl_xor(gq, o)); gk = fmaxf(gk, __shfl_xor(gk, o)); }
        if (lane == 0) *(float*)(ws + WS_CTL + 2048) = 2.0f * (8.0f * LOG2E * 1.02f * gq * gk) + 40.0f;
    }
#pragma unroll
    for (int i = 0; i < 8; ++i) { const int idx = tid + 512 * i, q = idx & 3, k = idx >> 2; const int col = (q < 2 ? 1536 : 3080) + 4 * (q & 1);
        const f32x4 w = *(const f32x4*)(w_in + (size_t)k * INW + col) * g_mix[k]; const int c0 = 4 * q;
        wgs[(c0 + 0) * 1024 + k] = w[0]; wgs[(c0 + 1) * 1024 + k] = w[1]; wgs[(c0 + 2) * 1024 + k] = w[2]; wgs[(c0 + 3) * 1024 + k] = w[3]; }
    constexpr int NITEMS = 16 * 176 + 8 * 32 + 8 * 32 + 16 * 32 + 16 * 176 + 44 * 32;
    __syncthreads();
    bf16* xb = (bf16*)(ws + WS_XB); float* rstd1 = (float*)(ws + WS_RSTD1);
    float* lfa = (float*)(ws + WS_LFA); float* li = (float*)(ws + WS_LI); float* lfb = (float*)(ws + WS_LFB);
    const int npair = (M / NGW) >> 1;
    f32x4 nA[4], nB[4], n2A[4], n2B[4];
    { const f32x4* xa = (const f32x4*)(x + (size_t)gw * 1024) + lane; const f32x4* xb_ = (const f32x4*)(x + (size_t)(gw + NGW) * 1024) + lane;
#pragma unroll
      for (int j = 0; j < 4; ++j) { nA[j] = xa[64 * j]; nB[j] = xb_[64 * j]; }
      const f32x4* xc = (const f32x4*)(x + (size_t)(gw + 2 * NGW) * 1024) + lane; const f32x4* xd = (const f32x4*)(x + (size_t)(gw + 3 * NGW) * 1024) + lane;
#pragma unroll
      for (int j = 0; j < 4; ++j) { n2A[j] = (f32x4){0.f, 0.f, 0.f, 0.f}; n2B[j] = n2A[j]; if (npair > 1) { n2A[j] = xc[64 * j]; n2B[j] = xd[64 * j]; } } }
    const int item_every = npair >= 4 ? (npair >> 2) : 1;
    for (int p = 0; p < npair; ++p) {
        const int rowA = gw + (2 * p) * NGW, rowB = rowA + NGW;
        const int itx = gw + (p / item_every) * NGW; const bool do_item = (p % item_every) == 0 && itx < NITEMS;
        P0Item itd{}; f32x4 wl[8]; float gvv[8];
        if (do_item) { itd = p0_decode(a, ws, itx); p0_item_issue(itd, wl, gvv, lane); }
        f32x4 vA[4], vB[4];
#pragma unroll
        for (int j = 0; j < 4; ++j) { vA[j] = nA[j]; vB[j] = nB[j]; nA[j] = n2A[j]; nB[j] = n2B[j]; }
        if (p + 2 < npair) { const f32x4* xa = (const f32x4*)(x + (size_t)(rowA + 4 * NGW) * 1024) + lane; const f32x4* xb_ = (const f32x4*)(x + (size_t)(rowB + 4 * NGW) * 1024) + lane;
#pragma unroll
            for (int j = 0; j < 4; ++j) { n2A[j] = xa[64 * j]; n2B[j] = xb_[64 * j]; } }
        float ssA = 0.f, ssB = 0.f;
#pragma unroll
        for (int j = 0; j < 4; ++j) { ssA += dot4(vA[j], vA[j]); ssB += dot4(vB[j], vB[j]); }
        { unsigned long long* oA = (unsigned long long*)(xb + (size_t)rowA * 1024) + lane; unsigned long long* oB = (unsigned long long*)(xb + (size_t)rowB * 1024) + lane;
#pragma unroll
          for (int j = 0; j < 4; ++j) { oA[64 * j] = (unsigned long long)pk2(vA[j][0], vA[j][1]) | ((unsigned long long)pk2(vA[j][2], vA[j][3]) << 32);
                                        oB[64 * j] = (unsigned long long)pk2(vB[j][0], vB[j][1]) | ((unsigned long long)pk2(vB[j][2], vB[j][3]) << 32); } }
        float acA[16], acB[16];
#pragma unroll
        for (int c = 0; c < 16; ++c) { float sA = 0.f, sB = 0.f;
#pragma unroll
            for (int j = 0; j < 4; ++j) { const f32x4 w = *(const LAS f32x4*)(wgs + c * 1024 + 256 * j + 4 * lane); sA += dot4(vA[j], w); sB += dot4(vB[j], w); }
            acA[c] = sA; acB[c] = sB; asm volatile("" ::: "memory"); }
#pragma unroll 1
        for (int rr = 0; rr < 2; ++rr) {
            float ac[16];
#pragma unroll
            for (int c = 0; c < 16; ++c) ac[c] = rr ? acB[c] : acA[c];
            const int row = rr ? rowB : rowA;
            const float ss = wave_sum(rr ? ssB : ssA);
            const float rstd = 1.0f / sqrtf(ss * (1.0f / 1024.0f) + EPS);
            { const bool hi = (lane & 32) != 0;
#pragma unroll
              for (int i = 0; i < 8; ++i) { const float keep = hi ? ac[i + 8] : ac[i], send = hi ? ac[i] : ac[i + 8]; ac[i] = keep + __shfl_xor(send, 32); } }
            { const bool hi = (lane & 16) != 0;
#pragma unroll
              for (int i = 0; i < 4; ++i) { const float keep = hi ? ac[i + 4] : ac[i], send = hi ? ac[i] : ac[i + 4]; ac[i] = keep + __shfl_xor(send, 16); } }
            { const bool hi = (lane & 8) != 0;
#pragma unroll
              for (int i = 0; i < 2; ++i) { const float keep = hi ? ac[i + 2] : ac[i], send = hi ? ac[i] : ac[i + 2]; ac[i] = keep + __shfl_xor(send, 8); } }
            { const bool hi = (lane & 4) != 0; const float keep = hi ? ac[1] : ac[0], send = hi ? ac[0] : ac[1]; ac[0] = keep + __shfl_xor(send, 4); }
            ac[0] += __shfl_xor(ac[0], 2); ac[0] += __shfl_xor(ac[0], 1);
            const int c = lane >> 2;
            if ((lane & 3) == 0) {
                const float z = rstd * ac[0]; const int bb = row >> 12, t = row & 4095;
                if (c < 8) lfa[((bb * 8 + c) << 12) + t] = logsigf_(z + a->in[3][c]);
                else if (c < 12) li[((bb * 4 + (c - 8)) << 12) + t] = z + a->in[8][c - 8];
                else lfb[((bb * 4 + (c - 12)) << 12) + t] = logsigf_(z + a->in[9][c - 12]);
            }
            if (lane == 0) rstd1[row] = rstd;
        }
        if (do_item) p0_item_finish(itd, wl, gvv, scr, lane);
    }
    for (int itx = gw + ((npair + item_every - 1) / item_every) * NGW; itx < NITEMS; itx += NGW) {
        const P0Item itd = p0_decode(a, ws, itx); f32x4 wl[8]; float gvv[8]; p0_item_issue(itd, wl, gvv, lane); p0_item_finish(itd, wl, gvv, scr, lane); }
}

__device__ __forceinline__ void cneg_scan(const float* lfa, float* cneg, int bh, LAS unsigned char* lds, int tid, int lane, int wave) {
    const f32x4* src = (const f32x4*)(lfa + (size_t)bh * 4096); f32x4* dst = (f32x4*)(cneg + (size_t)bh * 4096);
    const f32x4 a0 = src[2 * tid], a1 = src[2 * tid + 1];
    float p0 = a0[0], p1 = p0 + a0[1], p2 = p1 + a0[2], p3 = p2 + a0[3], p4 = p3 + a1[0], p5 = p4 + a1[1], p6 = p5 + a1[2], p7 = p6 + a1[3];
    float sc = p7;
#pragma unroll
    for (int o = 1; o < 64; o <<= 1) { const float nb = __shfl_up(sc, o); if (lane >= o) sc += nb; }
    LAS float* wt = (LAS float*)lds;
    if (lane == 63) wt[wave] = sc;
    __syncthreads();
    float off = sc - p7;
    for (int w = 0; w < wave; ++w) off += wt[w];
    f32x4 o0, o1;
    o0[0] = -(off + p0) * LOG2E; o0[1] = -(off + p1) * LOG2E; o0[2] = -(off + p2) * LOG2E; o0[3] = -(off + p3) * LOG2E;
    o1[0] = -(off + p4) * LOG2E; o1[1] = -(off + p5) * LOG2E; o1[2] = -(off + p6) * LOG2E; o1[3] = -(off + p7) * LOG2E;
    dst[2 * tid] = o0; dst[2 * tid + 1] = o1;
    __syncthreads();
}

__device__ __forceinline__ void fox_naive_unit(const bf16* qf, const bf16* kf, const bf16* vf, const float* cneg, bf16* ya, int b, int h, int qb, LAS unsigned char* lds, int tid, int wave) {
    LAS float* Ks = (LAS float*)lds; LAS float* Vs = Ks + 4096; LAS float* Bs = Vs + 4096;
    const int t = qb * 512 + tid; const size_t row = (size_t)b * SEQ + t;
    float q[64], o[64];
    { const v4u* qp = (const v4u*)(qf + row * 512 + h * 64);
#pragma unroll
      for (int i = 0; i < 8; ++i) { const v4u w = qp[i]; q[8 * i + 0] = bflo(w.x); q[8 * i + 1] = bfhi(w.x); q[8 * i + 2] = bflo(w.y); q[8 * i + 3] = bfhi(w.y); q[8 * i + 4] = bflo(w.z); q[8 * i + 5] = bfhi(w.z); q[8 * i + 6] = bflo(w.w); q[8 * i + 7] = bfhi(w.w); } }
#pragma unroll
    for (int d = 0; d < 64; ++d) o[d] = 0.f;
    float mx = -INFINITY, l = 0.f;
    const int ntiles = 8 * (qb + 1); const int wave_tmax = qb * 512 + wave * 64 + 63;
    for (int kt = 0; kt < ntiles; ++kt) {
        __syncthreads();
        { const int key = tid >> 3, ch = tid & 7; const size_t gr = ((size_t)b * SEQ + 64 * kt + key) * 512 + h * 64 + 8 * ch;
          const v4u kw = *(const v4u*)(kf + gr), vw = *(const v4u*)(vf + gr);
          f32x4 k0 = {bflo(kw.x), bfhi(kw.x), bflo(kw.y), bfhi(kw.y)}, k1 = {bflo(kw.z), bfhi(kw.z), bflo(kw.w), bfhi(kw.w)};
          f32x4 v0 = {bflo(vw.x), bfhi(vw.x), bflo(vw.y), bfhi(vw.y)}, v1 = {bflo(vw.z), bfhi(vw.z), bflo(vw.w), bfhi(vw.w)};
          *(LAS f32x4*)(Ks + key * 64 + 8 * ch) = k0; *(LAS f32x4*)(Ks + key * 64 + 8 * ch + 4) = k1;
          *(LAS f32x4*)(Vs + key * 64 + 8 * ch) = v0; *(LAS f32x4*)(Vs + key * 64 + 8 * ch + 4) = v1;
          if (tid < 64) Bs[tid] = cneg[((size_t)(b * 8 + h) << 12) + 64 * kt + tid]; }
        __syncthreads();
        if (64 * kt <= wave_tmax) {
            for (int g = 0; g < 8; ++g) {
                float s[8];
#pragma unroll
                for (int j = 0; j < 8; ++j) { const int key = 8 * g + j; float ac = 0.f;
#pragma unroll
                    for (int d4 = 0; d4 < 16; ++d4) { const f32x4 kk = *(const LAS f32x4*)(Ks + key * 64 + 4 * d4); ac += q[4 * d4] * kk[0] + q[4 * d4 + 1] * kk[1] + q[4 * d4 + 2] * kk[2] + q[4 * d4 + 3] * kk[3]; }
                    ac += Bs[key]; s[j] = (64 * kt + key > t) ? -INFINITY : ac; }
                float gm = s[0];
#pragma unroll
                for (int j = 1; j < 8; ++j) gm = fmaxf(gm, s[j]);
                const float mn = fmaxf(mx, gm);
                if (mn > -INFINITY) {
                    const float alpha = exp2f(mx - mn); mx = mn;
                    float p[8]; float ps = 0.f;
#pragma unroll
                    for (int j = 0; j < 8; ++j) { p[j] = exp2f(s[j] - mn); ps += p[j]; }
                    l = l * alpha + ps;
#pragma unroll
                    for (int d4 = 0; d4 < 16; ++d4) {
                        float o0 = o[4 * d4] * alpha, o1 = o[4 * d4 + 1] * alpha, o2 = o[4 * d4 + 2] * alpha, o3 = o[4 * d4 + 3] * alpha;
#pragma unroll
                        for (int j = 0; j < 8; ++j) { const f32x4 vv = *(const LAS f32x4*)(Vs + (8 * g + j) * 64 + 4 * d4); o0 += p[j] * vv[0]; o1 += p[j] * vv[1]; o2 += p[j] * vv[2]; o3 += p[j] * vv[3]; }
                        o[4 * d4] = o0; o[4 * d4 + 1] = o1; o[4 * d4 + 2] = o2; o[4 * d4 + 3] = o3;
                    }
                }
            }
        }
    }
    const float inv = 1.0f / l;
    v4u* op = (v4u*)(ya + row * 512 + h * 64);
#pragma unroll
    for (int i = 0; i < 8; ++i) { v4u w; w.x = pk2(o[8 * i] * inv, o[8 * i + 1] * inv); w.y = pk2(o[8 * i + 2] * inv, o[8 * i + 3] * inv); w.z = pk2(o[8 * i + 4] * inv, o[8 * i + 5] * inv); w.w = pk2(o[8 * i + 6] * inv, o[8 * i + 7] * inv); op[i] = w; }
}

__device__ __forceinline__ void mlstm_naive_unit(KArgs a, int b, int h, LAS unsigned char* lds, int tid, int lane, int wave) {
    unsigned char* ws = a->ws;
    const bf16* mq = (const bf16*)(ws + WS_MQ); const bf16* mk = (const bf16*)(ws + WS_MK); const bf16* mv = (const bf16*)(ws + WS_MV); const bf16* sob = (const bf16*)(ws + WS_SOB);
    const float* lig = (const float*)(ws + WS_LI) + ((size_t)(b * 4 + h) << 12); const float* lfg = (const float*)(ws + WS_LFB) + ((size_t)(b * 4 + h) << 12);
    bf16* yb = (bf16*)(ws + WS_YB);
    const float* conv_w = a->in[6]; const float* conv_b = a->in[7]; const float* gh = a->in[10];
    LAS float* qs = (LAS float*)lds; LAS float* ks = qs + 64 * 144; LAS float* vs = ks + 64 * 144; LAS float* hs = vs + 64 * 128; LAS float* gl = hs + 64 * 128;
    const int v = tid >> 2, kq = tid & 3;
    float C[32], nn[32];
#pragma unroll
    for (int j = 0; j < 32; ++j) { C[j] = 0.f; nn[j] = 0.f; }
    float mst = 0.f;
    for (int bt = 0; bt < 64; ++bt) {
        const int t0 = bt * 64;
        __syncthreads();
        { const int c = tid & 127, tg = tid >> 7;
#pragma unroll
          for (int which = 0; which < 2; ++which) {
              const bf16* src = which ? mk : mq; LAS float* dst = which ? ks : qs; const int chan = which * 512 + h * 128 + c;
              const float w0 = conv_w[chan], w1 = conv_w[1024 + chan], w2 = conv_w[2048 + chan], w3 = conv_w[3072 + chan], cb = conv_b[chan];
              const float post = which ? 0.08838834764831845f : 1.0f;
              const int ts = t0 + 16 * tg; const bf16* sp = src + ((size_t)b * SEQ) * 512 + h * 128 + c;
              float um3 = ts >= 3 ? bf2f(sp[(size_t)(ts - 3) * 512]) : 0.f, um2 = ts >= 2 ? bf2f(sp[(size_t)(ts - 2) * 512]) : 0.f, um1 = ts >= 1 ? bf2f(sp[(size_t)(ts - 1) * 512]) : 0.f;
              for (int i = 0; i < 16; ++i) { const float uu = bf2f(sp[(size_t)(ts + i) * 512]); const float y = cb + w0 * um3 + w1 * um2 + w2 * um1 + w3 * uu;
                  dst[(16 * tg + i) * 144 + (c >> 5) * 36 + (c & 31)] = y * sigmoidf_(y) * post; um3 = um2; um2 = um1; um1 = uu; }
          }
          for (int i = 0; i < 16; ++i) { const int idx = tid + 512 * i, tok = idx >> 7, cc = idx & 127; vs[tok * 128 + cc] = bf2f(mv[((size_t)b * SEQ + t0 + tok) * 512 + h * 128 + cc]); }
          if (tid < 64) { gl[tid] = lig[t0 + tid]; gl[64 + tid] = lfg[t0 + tid]; } }
        __syncthreads();
        for (int tt = 0; tt < 64; ++tt) {
            const float li_t = gl[tt], lf_t = gl[64 + tt];
            const float mn = fmaxf(lf_t + mst, li_t); const float fdec = __expf(lf_t + mst - mn), iw = __expf(li_t - mn); mst = mn;
            const float ivt = iw * vs[tt * 128 + v];
            float num = 0.f, den = 0.f;
#pragma unroll
            for (int j4 = 0; j4 < 8; ++j4) { const f32x4 kk = *(const LAS f32x4*)(ks + tt * 144 + kq * 36 + 4 * j4), qq = *(const LAS f32x4*)(qs + tt * 144 + kq * 36 + 4 * j4);
#pragma unroll
                for (int e = 0; e < 4; ++e) { const int j = 4 * j4 + e; C[j] = fdec * C[j] + ivt * kk[e]; nn[j] = fdec * nn[j] + iw * kk[e]; num += C[j] * qq[e]; den += nn[j] * qq[e]; } }
            num += __shfl_xor(num, 1); num += __shfl_xor(num, 2); den += __shfl_xor(den, 1); den += __shfl_xor(den, 2);
            const float hv = num / fmaxf(fabsf(den), __expf(-mst));
            if (kq == 0) hs[tt * 128 + v] = hv;
        }
        __syncthreads();
        for (int i = 0; i < 8; ++i) { const int tok = 8 * wave + i; const float x0 = hs[tok * 128 + lane], x1 = hs[tok * 128 + 64 + lane];
            const float mean = wave_sum(x0 + x1) * (1.0f / 128.0f); const float d0 = x0 - mean, d1 = x1 - mean;
            const float var = wave_sum(d0 * d0 + d1 * d1) * (1.0f / 128.0f); const float r = 1.0f / sqrtf(var + EPS);
            const size_t rowo = ((size_t)b * SEQ + t0 + tok) * 512 + h * 128;
            yb[rowo + lane] = (bf16)f2bf(d0 * r * gh[h * 128 + lane] * bf2f(sob[rowo + lane]));
            yb[rowo + 64 + lane] = (bf16)f2bf(d1 * r * gh[h * 128 + 64 + lane] * bf2f(sob[rowo + 64 + lane])); }
    }
}

constexpr size_t WS_GB = WS_SM + 13 * MiB, WS_GG = WS_SM + 14 * MiB, WS_GM = WS_SM + 15 * MiB, WS_MC = WS_SM + 16 * MiB;

__device__ __forceinline__ void mlstm_gate_prepass(const float* li, const float* lfb, float* gb, float* gg, float* gM, float* mc, int bh, LAS unsigned char* lds, int tid) {
    const f32x4* lf4 = (const f32x4*)(lfb + (size_t)bh * 4096); const f32x4* li4 = (const f32x4*)(li + (size_t)bh * 4096);
    const f32x4 f0 = lf4[2 * tid], f1 = lf4[2 * tid + 1], i0 = li4[2 * tid], i1 = li4[2 * tid + 1];
    float bb[8]; bb[0] = f0[0]; bb[1] = bb[0] + f0[1]; bb[2] = bb[1] + f0[2]; bb[3] = bb[2] + f0[3]; bb[4] = bb[3] + f1[0]; bb[5] = bb[4] + f1[1]; bb[6] = bb[5] + f1[2]; bb[7] = bb[6] + f1[3];
    float sc = bb[7];
#pragma unroll
    for (int o = 1; o < 16; o <<= 1) { const float nb = __shfl_up(sc, o, 16); if ((tid & 15) >= o) sc += nb; }
    const float off = sc - bb[7];
    float gv[8], mv[8];
    const float lis[8] = {i0[0], i0[1], i0[2], i0[3], i1[0], i1[1], i1[2], i1[3]};
#pragma unroll
    for (int e = 0; e < 8; ++e) { bb[e] += off; gv[e] = lis[e] - bb[e]; mv[e] = e ? fmaxf(mv[e - 1], gv[e]) : gv[0]; }
    float mx = mv[7];
#pragma unroll
    for (int o = 1; o < 16; o <<= 1) { const float nb = __shfl_up(mx, o, 16); if ((tid & 15) >= o) mx = fmaxf(mx, nb); }
    const float prev = __shfl_up(mx, 1, 16);
    if ((tid & 15) != 0) {
#pragma unroll
        for (int e = 0; e < 8; ++e) mv[e] = fmaxf(mv[e], prev);
    }
    f32x4* gb4 = (f32x4*)(gb + (size_t)bh * 4096); f32x4* gg4 = (f32x4*)(gg + (size_t)bh * 4096); f32x4* gM4 = (f32x4*)(gM + (size_t)bh * 4096);
    gb4[2 * tid] = (f32x4){bb[0], bb[1], bb[2], bb[3]}; gb4[2 * tid + 1] = (f32x4){bb[4], bb[5], bb[6], bb[7]};
    gg4[2 * tid] = (f32x4){gv[0], gv[1], gv[2], gv[3]}; gg4[2 * tid + 1] = (f32x4){gv[4], gv[5], gv[6], gv[7]};
    gM4[2 * tid] = (f32x4){mv[0], mv[1], mv[2], mv[3]}; gM4[2 * tid + 1] = (f32x4){mv[4], mv[5], mv[6], mv[7]};
    LAS float* cl = (LAS float*)lds;
    if ((tid & 15) == 15) { cl[tid >> 4] = bb[7]; cl[32 + (tid >> 4)] = mv[7]; }
    __syncthreads();
    if (tid == 0) { float m = 0.f; for (int c = 0; c < 32; ++c) { mc[bh * 32 + c] = m; m = cl[c] + fmaxf(m, cl[32 + c]); } }
    __syncthreads();
}

namespace ml {
typedef short bf16x8 __attribute__((ext_vector_type(8)));
typedef short s16x4 __attribute__((ext_vector_type(4)));
constexpr int PITCH = 136;
constexpr int TILE_B = 128 * PITCH * 2;
constexpr int O_KS = 0, O_KT = TILE_B, O_VT = 2 * TILE_B, O_CB = 3 * TILE_B, O_SM = 4 * TILE_B;
constexpr int O_GS = O_SM, O_MU = O_SM + 512, O_WI = O_SM + 1024, O_EM = O_SM + 1536, O_WS = O_SM + 2048, O_N = O_SM + 2560, O_NP = O_SM + 3072  , O_GH = O_SM + 5120, O_CW = O_SM + 5632  , O_KW = O_SM + 8192  , O_SC = O_SM + 10752, O_END = O_SM + 10816;
static_assert(O_END <= LDS_BYTES - 64, "mLSTM LDS map");
__device__ __forceinline__ unsigned pkbf(float lo, float hi) { return pg8::cvt_pk_bf16(lo, hi); }
}

__device__ __forceinline__ void mlstm_fast_unit(KArgs a, int b, int h, LAS unsigned char* lds, int tid, int lane, int wave) {
    using namespace ml;
    unsigned char* ws = a->ws;
    const bf16* mq = (const bf16*)(ws + WS_MQ); const bf16* mk = (const bf16*)(ws + WS_MK); const bf16* mv = (const bf16*)(ws + WS_MV); const bf16* sob = (const bf16*)(ws + WS_SOB);
    bf16* yb = (bf16*)(ws + WS_YB);
    const int bh = b * 4 + h;
    const float* gbp = (const float*)(ws + WS_GB) + (size_t)bh * 4096; const float* ggp = (const float*)(ws + WS_GG) + (size_t)bh * 4096; const float* gMp = (const float*)(ws + WS_GM) + (size_t)bh * 4096;
    const float* mcp = (const float*)(ws + WS_MC) + bh * 32;
    const float* conv_w = a->in[6]; const float* conv_b = a->in[7];
    LAS bf16* KS = (LAS bf16*)(lds + O_KS); LAS bf16* KT = (LAS bf16*)(lds + O_KT); LAS bf16* VT = (LAS bf16*)(lds + O_VT); LAS bf16* CB = (LAS bf16*)(lds + O_CB);
    LAS float* gs = (LAS float*)(lds + O_GS); LAS float* mus = (LAS float*)(lds + O_MU); LAS float* wis = (LAS float*)(lds + O_WI); LAS float* ems = (LAS float*)(lds + O_EM); LAS float* wss = (LAS float*)(lds + O_WS);
    LAS float* nst = (LAS float*)(lds + O_N); LAS float* npart = (LAS float*)(lds + O_NP); LAS float* ghs = (LAS float*)(lds + O_GH); LAS float* cws = (LAS float*)(lds + O_CW); LAS float* scal = (LAS float*)(lds + O_SC);
    const int c16 = lane & 15, g = lane >> 4;
    __syncthreads();
    for (int i = tid; i < TILE_B / 4; i += 512) ((LAS unsigned*)CB)[i] = 0u;
    if (tid < 128) { nst[tid] = 0.f; ghs[tid] = a->in[10][h * 128 + tid]; }
    LAS float* kws = (LAS float*)(lds + O_KW);
    for (int i = tid; i < 640; i += 512) { const int tap = i >> 7, ch = i & 127; cws[i] = tap < 4 ? conv_w[tap * 1024 + h * 128 + ch] : conv_b[h * 128 + ch];
        kws[i] = tap < 4 ? conv_w[tap * 1024 + 512 + h * 128 + ch] : conv_b[512 + h * 128 + ch]; }
    const int ch8 = tid & 15, tq = tid >> 4;
    v4u kr[7], vr[4];
#define ML_LOAD_KV(cc) do { const int tb_ = (cc) * 128 + 4 * tq; const size_t ro_ = ((size_t)b * SEQ + tb_) * 512 + h * 128 + 8 * ch8; \
        _Pragma("unroll") for (int r_ = 0; r_ < 7; ++r_) { kr[r_] = (v4u){0u, 0u, 0u, 0u}; if (tb_ - 3 + r_ >= 0) kr[r_] = *(const v4u*)(mk + ro_ + (r_ - 3) * 512); } \
        _Pragma("unroll") for (int r_ = 0; r_ < 4; ++r_) vr[r_] = *(const v4u*)(mv + ro_ + r_ * 512); } while (0)
    v4u qraw[4][4]; float tbM = 0.f, tbB = 0.f, tbG = 0.f, tbL = 0.f, tbm = 0.f;
#define ML_LOAD_Q(J0, cc) do { const int tglob = (cc) * 128 + 16 * wave + c16; const bf16* qp = mq + ((size_t)b * SEQ + tglob) * 512 + h * 128 + 8 * g; \
          _Pragma("unroll") for (int j = (J0); j < (J0) + 2; ++j) { \
              _Pragma("unroll") for (int r = 0; r < 4; ++r) { qraw[j][r] = (v4u){0u, 0u, 0u, 0u}; if (tglob - 3 + r >= 0) qraw[j][r] = *(const v4u*)(qp + (r - 3) * 512 + 32 * j); } } } while (0)
#define ML_LOAD_TB(cc) do { tbm = mcp[(cc)]; tbL = gMp[(cc) * 128 + 127]; if (tid < 128) { tbM = gMp[(cc) * 128 + tid]; tbB = gbp[(cc) * 128 + tid]; tbG = ggp[(cc) * 128 + tid]; } } while (0)
#define ML_BAR() asm volatile("s_waitcnt lgkmcnt(0)\n\ts_barrier" ::: "memory")
    ML_LOAD_TB(0);
    f32x4 Cst[8];
#pragma unroll
    for (int kb = 0; kb < 8; ++kb) Cst[kb] = (f32x4){0.f, 0.f, 0.f, 0.f};
    __syncthreads();

    for (int c = 0; c < 32; ++c) {
        const int t0 = c * 128;
        const size_t rowb = (size_t)b * SEQ + t0;
        ML_LOAD_KV(c); ML_LOAD_Q(0, c);
        {
            unsigned ksw[4][4];
#pragma unroll
            for (int wd = 0; wd < 4; ++wd) {
                float kk[4][2];
                typedef float f32x2_ __attribute__((ext_vector_type(2)));
                const f32x2_ kw0 = *(const LAS f32x2_*)(kws + 8 * ch8 + 2 * wd), kw1 = *(const LAS f32x2_*)(kws + 128 + 8 * ch8 + 2 * wd), kw2 = *(const LAS f32x2_*)(kws + 256 + 8 * ch8 + 2 * wd), kw3 = *(const LAS f32x2_*)(kws + 384 + 8 * ch8 + 2 * wd), kwb = *(const LAS f32x2_*)(kws + 512 + 8 * ch8 + 2 * wd);
#pragma unroll
                for (int hf = 0; hf < 2; ++hf) {
                    const float w0 = kw0[hf], w1 = kw1[hf], w2 = kw2[hf], w3 = kw3[hf], cb = kwb[hf];
                    float u[7];
#pragma unroll
                    for (int r = 0; r < 7; ++r) { const unsigned w = wd == 0 ? kr[r].x : wd == 1 ? kr[r].y : wd == 2 ? kr[r].z : kr[r].w; u[r] = hf ? bfhi(w) : bflo(w); }
#pragma unroll
                    for (int i = 0; i < 4; ++i) { const float y = cb + w0 * u[i] + w1 * u[i + 1] + w2 * u[i + 2] + w3 * u[i + 3]; kk[i][hf] = y * sigmoidf_(y) * 0.08838834764831845f; }
                }
#pragma unroll
                for (int i = 0; i < 4; ++i) ksw[i][wd] = pkbf(kk[i][0], kk[i][1]);
#pragma unroll
                for (int hf = 0; hf < 2; ++hf) { const int row = 8 * ch8 + 2 * wd + hf; const int gr = (tq >> 1) ^ ch8;
                    const unsigned long long kt = (unsigned long long)pkbf(kk[0][hf], kk[1][hf]) | ((unsigned long long)pkbf(kk[2][hf], kk[3][hf]) << 32);
                    *(LAS unsigned long long*)(KT + row * PITCH + 8 * gr + 4 * (tq & 1)) = kt;
                    const unsigned v0 = wd == 0 ? vr[0].x : wd == 1 ? vr[0].y : wd == 2 ? vr[0].z : vr[0].w, v1 = wd == 0 ? vr[1].x : wd == 1 ? vr[1].y : wd == 2 ? vr[1].z : vr[1].w;
                    const unsigned v2 = wd == 0 ? vr[2].x : wd == 1 ? vr[2].y : wd == 2 ? vr[2].z : vr[2].w, v3 = wd == 0 ? vr[3].x : wd == 1 ? vr[3].y : wd == 2 ? vr[3].z : vr[3].w;
                    const unsigned lo = hf ? ((v0 >> 16) | (v1 & 0xffff0000u)) : ((v0 & 0xffffu) | (v1 << 16)), hi = hf ? ((v2 >> 16) | (v3 & 0xffff0000u)) : ((v2 & 0xffffu) | (v3 << 16));
                    *(LAS unsigned long long*)(VT + row * PITCH + 8 * gr + 4 * (tq & 1)) = (unsigned long long)lo | ((unsigned long long)hi << 32); }
                asm volatile("" ::: "memory");
            }
#pragma unroll
            for (int i = 0; i < 4; ++i) *(LAS v4u*)(KS + (4 * tq + i) * PITCH + 8 * ch8) = (v4u){ksw[i][0], ksw[i][1], ksw[i][2], ksw[i][3]};
            asm volatile("" ::: "memory");
            ML_LOAD_Q(2, c);
            if (tid < 128) {
                const float m = tbm, Mt = tbM, bt = tbB, gt = tbG, Ml = tbL;
                const float mu = fmaxf(m, Mt), mul = fmaxf(m, Ml);
                gs[tid] = gt; mus[tid] = mu; wis[tid] = __expf(m - mu); ems[tid] = __expf(-(bt + mu)); wss[tid] = __expf(gt - mul);
                if (tid == 0) scal[0] = __expf(m - mul);
            }
        }
        bf16x8 Qf[4]; float qn = 0.f;
#pragma unroll
        for (int j = 0; j < 4; ++j) {
            unsigned qw[4];
#pragma unroll
            for (int hh = 0; hh < 2; ++hh) {
                f32x4 cw[5];
#pragma unroll
                for (int tp = 0; tp < 5; ++tp) cw[tp] = *(const LAS f32x4*)(cws + tp * 128 + 32 * j + 8 * g + 4 * hh);
                float q4[4];
#pragma unroll
                for (int e4 = 0; e4 < 4; ++e4) {
                    const int wd = 2 * hh + (e4 >> 1);
                    const unsigned w0 = wd == 0 ? qraw[j][0].x : wd == 1 ? qraw[j][0].y : wd == 2 ? qraw[j][0].z : qraw[j][0].w, w1 = wd == 0 ? qraw[j][1].x : wd == 1 ? qraw[j][1].y : wd == 2 ? qraw[j][1].z : qraw[j][1].w;
                    const unsigned w2 = wd == 0 ? qraw[j][2].x : wd == 1 ? qraw[j][2].y : wd == 2 ? qraw[j][2].z : qraw[j][2].w, w3 = wd == 0 ? qraw[j][3].x : wd == 1 ? qraw[j][3].y : wd == 2 ? qraw[j][3].z : qraw[j][3].w;
                    const float u0 = (e4 & 1) ? bfhi(w0) : bflo(w0), u1 = (e4 & 1) ? bfhi(w1) : bflo(w1), u2 = (e4 & 1) ? bfhi(w2) : bflo(w2), u3 = (e4 & 1) ? bfhi(w3) : bflo(w3);
                    const float y = cw[4][e4] + cw[0][e4] * u0 + cw[1][e4] * u1 + cw[2][e4] * u2 + cw[3][e4] * u3;
                    q4[e4] = y * sigmoidf_(y);
                }
                qw[2 * hh] = pkbf(q4[0], q4[1]); qw[2 * hh + 1] = pkbf(q4[2], q4[3]);
                asm volatile("" ::: "memory");
            }
            Qf[j] = __builtin_bit_cast(bf16x8, (v4u){qw[0], qw[1], qw[2], qw[3]});
        }
        ML_BAR();
        if (c + 1 < 32) { ML_LOAD_TB(c + 1); }
        unsigned long long sow[8];
        { const size_t ro = (rowb + 16 * wave + c16) * 512 + h * 128 + 4 * g;
#pragma unroll
          for (int vt = 0; vt < 8; ++vt) sow[vt] = *(const unsigned long long*)(sob + ro + 16 * vt); }
        const int tl = 16 * wave + c16;
        const float mu_t = mus[tl], wi_t = wis[tl], em_t = ems[tl];
        {
#pragma unroll
            for (int j = 0; j < 4; ++j) { const v4u qq = __builtin_bit_cast(v4u, Qf[j]); const LAS float* np = nst + 32 * j + 8 * g;
                const f32x4 n0 = *(const LAS f32x4*)np, n1 = *(const LAS f32x4*)(np + 4);
                qn += bflo(qq.x) * n0[0] + bfhi(qq.x) * n0[1] + bflo(qq.y) * n0[2] + bfhi(qq.y) * n0[3] + bflo(qq.z) * n1[0] + bfhi(qq.z) * n1[1] + bflo(qq.w) * n1[2] + bfhi(qq.w) * n1[3]; }
            qn += __shfl_xor(qn, 16); qn += __shfl_xor(qn, 32);
        }
        f32x4 acc[8];
#pragma unroll
        for (int vt = 0; vt < 8; ++vt) { f32x4 s = {0.f, 0.f, 0.f, 0.f};
#pragma unroll
            for (int j = 0; j < 4; ++j) { const bf16x8 af = *(const LAS bf16x8*)(CB + (16 * vt + c16) * PITCH + 32 * j + 8 * g); s = __builtin_amdgcn_mfma_f32_16x16x32_bf16(af, Qf[j], s, 0, 0, 0); }
            acc[vt] = s * wi_t; }
        float dsum = 0.f;
        for (int jj = 0; jj <= (wave >> 1); ++jj) {
            float pk[2][4];
#pragma unroll
            for (int half = 0; half < 2; ++half) {
                const int st = 2 * jj + half;
                if (st <= wave) {
                    f32x4 s = {0.f, 0.f, 0.f, 0.f};
#pragma unroll
                    for (int j = 0; j < 4; ++j) { const bf16x8 kf = *(const LAS bf16x8*)(KS + (16 * st + c16) * PITCH + 32 * j + 8 * g); s = __builtin_amdgcn_mfma_f32_16x16x32_bf16(kf, Qf[j], s, 0, 0, 0); }
                    const f32x4 gv = *(const LAS f32x4*)(gs + 16 * st + 4 * g);
#pragma unroll
                    for (int i = 0; i < 4; ++i) { float p = s[i] * __expf(fminf(gv[i] - mu_t, 0.f)); if (st == wave && 4 * g + i > c16) p = 0.f; pk[half][i] = p; dsum += p; }
                } else {
#pragma unroll
                    for (int i = 0; i < 4; ++i) pk[half][i] = 0.f;
                }
            }
            v4u pb; pb.x = pkbf(pk[0][0], pk[0][1]); pb.y = pkbf(pk[0][2], pk[0][3]); pb.z = pkbf(pk[1][0], pk[1][1]); pb.w = pkbf(pk[1][2], pk[1][3]);
            const bf16x8 bfr = __builtin_bit_cast(bf16x8, pb);
#pragma unroll
            for (int vt = 0; vt < 8; ++vt) {
                const LAS bf16* vrow = VT + (16 * vt + c16) * PITCH + 4 * (g & 1); const int rsw = 2 * vt + (c16 >> 3), g0 = 4 * jj + (g >> 1);
                const s16x4 lo = *(const LAS s16x4*)(vrow + 8 * (g0 ^ rsw)), hi = *(const LAS s16x4*)(vrow + 8 * ((g0 + 2) ^ rsw));
                const bf16x8 af = (bf16x8){lo[0], lo[1], lo[2], lo[3], hi[0], hi[1], hi[2], hi[3]};
                acc[vt] = __builtin_amdgcn_mfma_f32_16x16x32_bf16(af, bfr, acc[vt], 0, 0, 0);
            }
        }
        dsum += __shfl_xor(dsum, 16); dsum += __shfl_xor(dsum, 32);
        {
            const float den = wi_t * qn + dsum; const float inv = __builtin_amdgcn_rcpf(fmaxf(fabsf(den), em_t));
            float sm = 0.f;
#pragma unroll
            for (int vt = 0; vt < 8; ++vt) { acc[vt] = acc[vt] * inv; sm += (acc[vt][0] + acc[vt][1]) + (acc[vt][2] + acc[vt][3]); }
            sm += __shfl_xor(sm, 16); sm += __shfl_xor(sm, 32);
            const float mean = sm * (1.0f / 128.0f); float sq = 0.f;
#pragma unroll
            for (int vt = 0; vt < 8; ++vt) { acc[vt] = acc[vt] - mean; sq += dot4(acc[vt], acc[vt]); }
            sq += __shfl_xor(sq, 16); sq += __shfl_xor(sq, 32);
            const float r = __builtin_amdgcn_rsqf(sq * (1.0f / 128.0f) + EPS);
            const size_t ro = (rowb + tl) * 512 + h * 128 + 4 * g;
#pragma unroll
            for (int vt = 0; vt < 8; ++vt) {
                const unsigned long long sw = sow[vt]; const unsigned s0 = (unsigned)sw, s1 = (unsigned)(sw >> 32);
                const f32x4 gh4 = *(const LAS f32x4*)(ghs + 16 * vt + 4 * g);
                const float y0 = acc[vt][0] * r * gh4[0] * bflo(s0), y1 = acc[vt][1] * r * gh4[1] * bfhi(s0), y2 = acc[vt][2] * r * gh4[2] * bflo(s1), y3 = acc[vt][3] * r * gh4[3] * bfhi(s1);
                *(unsigned long long*)(yb + ro + 16 * vt) = (unsigned long long)pkbf(y0, y1) | ((unsigned long long)pkbf(y2, y3) << 32);
            }
        }
        ML_BAR();
        const float decay = scal[0];
        {
            bf16x8 Vw[4];
#pragma unroll
            for (int j = 0; j < 4; ++j) {
                const v4u vr_ = *(const LAS v4u*)(VT + (16 * wave + c16) * PITCH + 8 * ((4 * j + g) ^ (2 * wave + (c16 >> 3))));
                const f32x4 w0 = *(const LAS f32x4*)(wss + 32 * j + 8 * g), w1 = *(const LAS f32x4*)(wss + 32 * j + 8 * g + 4);
                v4u o; o.x = pkbf(bflo(vr_.x) * w0[0], bfhi(vr_.x) * w0[1]); o.y = pkbf(bflo(vr_.y) * w0[2], bfhi(vr_.y) * w0[3]); o.z = pkbf(bflo(vr_.z) * w1[0], bfhi(vr_.z) * w1[1]); o.w = pkbf(bflo(vr_.w) * w1[2], bfhi(vr_.w) * w1[3]);
                Vw[j] = __builtin_bit_cast(bf16x8, o);
            }
#pragma unroll
            for (int kb = 0; kb < 8; ++kb) {
                f32x4 s = Cst[kb] * decay;
#pragma unroll
                for (int j = 0; j < 4; ++j) { const bf16x8 kf = *(const LAS bf16x8*)(KT + (16 * kb + c16) * PITCH + 8 * ((4 * j + g) ^ (2 * kb + (c16 >> 3)))); s = __builtin_amdgcn_mfma_f32_16x16x32_bf16(Vw[j], kf, s, 0, 0, 0); }
                Cst[kb] = s;
#pragma unroll
                for (int i = 0; i < 4; ++i) CB[(16 * wave + 4 * g + i) * PITCH + 16 * kb + c16] = (bf16)f2bf(s[i]);
            }
            { const int k = tid & 127, part = tid >> 7; float s = 0.f;
#pragma unroll
              for (int q4 = 0; q4 < 4; ++q4) { const v4u kr_ = *(const LAS v4u*)(KT + k * PITCH + 8 * ((4 * part + q4) ^ ((k >> 3) & 15)));
                  const f32x4 w0 = *(const LAS f32x4*)(wss + 32 * part + 8 * q4), w1 = *(const LAS f32x4*)(wss + 32 * part + 8 * q4 + 4);
                  s += bflo(kr_.x) * w0[0] + bfhi(kr_.x) * w0[1] + bflo(kr_.y) * w0[2] + bfhi(kr_.y) * w0[3] + bflo(kr_.z) * w1[0] + bfhi(kr_.z) * w1[1] + bflo(kr_.w) * w1[2] + bfhi(kr_.w) * w1[3]; }
              npart[part * 128 + k] = s; }
        }
        ML_BAR();
        if (tid < 128) nst[tid] = decay * nst[tid] + ((npart[tid] + npart[128 + tid]) + (npart[256 + tid] + npart[384 + tid]));
    }
    __syncthreads();
#undef ML_LOAD_KV
#undef ML_LOAD_Q
#undef ML_LOAD_TB
#undef ML_BAR
}
constexpr int RS_OFF = 131072, RS_SLOTS = 6;
template <int MODE> __device__ __forceinline__ int stage_row_scales(const pg8::StaticOrder& S, const float* src, LAS unsigned char* lds, int tid) {
    pg8::Unit u0; if (!S.next(0, u0)) return 0;
    const int g0 = u0.pm >> 3, plo = u0.pm & 7; LAS float* rsl = (LAS float*)(lds + RS_OFF);
    if (tid < 256) {
#pragma unroll
        for (int s = 0; s < RS_SLOTS; ++s) { const int pm_s = ((g0 + s) << 3) | plo; if (pm_s < M / 256) { const int row = pm_s * 256 + tid;
            if (MODE == 0) rsl[s * 256 + tid] = src[row];
            else { const f32x4* sp = (const f32x4*)(src + (size_t)row * 16); const f32x4 s0 = sp[0], s1 = sp[1], s2 = sp[2], s3 = sp[3];
                const float tot = ((s0[0] + s0[1]) + (s0[2] + s0[3])) + ((s1[0] + s1[1]) + (s1[2] + s1[3])) + ((s2[0] + s2[1]) + (s2[2] + s2[3])) + ((s3[0] + s3[1]) + (s3[2] + s3[3]));
                rsl[s * 256 + tid] = __builtin_amdgcn_rsqf(tot * (1.0f / 1024.0f) + EPS); } } }
    }
    __syncthreads();
    return g0;
}

__global__ void __launch_bounds__(512, 2) fwd_megakernel(Args a) {
    extern __shared__ __attribute__((aligned(16))) unsigned char lds_raw[];
    LAS unsigned char* lds = (LAS unsigned char*)lds_raw;
    cg::grid_group grid = cg::this_grid();
    const int wave = __builtin_amdgcn_readfirstlane((int)threadIdx.x >> 6);
    if (threadIdx.x < 2) ((LAS unsigned*)(lds + LDS_BYTES - 32))[threadIdx.x] = 0u;
    __syncthreads();
#define GRID_BAR() do { XcdBarrier bar_; bar_.bar = (unsigned*)(kargs()->ws + WS_BAR); bar_.x = xb_xcc_id(); bar_.st = (volatile LAS unsigned*)(lds + LDS_BYTES - 32); xcd_barrier(bar_); } while (0)
#define FRESH_LANE() int lane = __builtin_amdgcn_mbcnt_hi(~0u, __builtin_amdgcn_mbcnt_lo(~0u, 0u)); asm volatile("" : "+v"(lane)); const int tid = wave * 64 + lane; (void)tid
    const int G = gridDim.x;

    if (PH & 1) { FRESH_LANE(); p0_phase(kargs(), lds, tid, lane, wave); }
    grid.sync();
    (void)xcd_barrier_post((unsigned*)(kargs()->ws + WS_BAR), (volatile LAS unsigned*)(lds + LDS_BYTES - 32));

    if (PH & 2) { FRESH_LANE(); unsigned char* ws = kargs()->ws; for (int bh = blockIdx.x; bh < 128; bh += G) cneg_scan((const float*)(ws + WS_LFA), (float*)(ws + WS_CNEG), bh, lds, tid, lane, wave);
        for (int u = (int)blockIdx.x - 128; u >= 0 && u < 64; u += G) mlstm_gate_prepass((const float*)(ws + WS_LI), (const float*)(ws + WS_LFB), (float*)(ws + WS_GB), (float*)(ws + WS_GG), (float*)(ws + WS_GM), (float*)(ws + WS_MC), u, lds, tid); }
    if (PH & 2) {
        KArgs ka = kargs(); unsigned char* ws = ka->ws;
        pg8::Gemm g{(const bf16*)(ws + WS_XB), (const bf16*)(ws + WS_BT1) + (size_t)14 * 256 * 1024, M, 2048, 1024}; pg8::StaticOrder S; S.init(M, 2048, G, (int)blockIdx.x);
        int g0; { FRESH_LANE(); g0 = stage_row_scales<0>(S, (const float*)(ws + WS_RSTD1), lds, tid); }
        Epi1 E{(const LAS float*)(lds + RS_OFF), g0, (bf16*)(ws + WS_QF), (bf16*)(ws + WS_KF), (bf16*)(ws + WS_VF), (bf16*)(ws + WS_SGA), ka->in[4], ka->in[5], 14};
        pg8::gemm_phase<Epi1, pg8::StaticOrder, true, true>(lds, g, S, E, wave);
    }
    GRID_BAR();

    {
        constexpr int NML = 64;
        unsigned* const sbar = (unsigned*)(kargs()->ws + WS_CTL) + 64 * 4;
        if ((int)blockIdx.x < NML) {
            if (PH & 4) { FRESH_LANE(); mlstm_fast_unit(kargs(), (int)blockIdx.x >> 2, (int)blockIdx.x & 3, lds, tid, lane, wave); }
        } else {
            if (PH & 2) {
                KArgs ka = kargs(); unsigned char* ws = ka->ws;
                pg8::Gemm g{(const bf16*)(ws + WS_XB), (const bf16*)(ws + WS_BT1), M, 3584, 1024}; pg8::StaticOrder S; S.init(M, 3584, G - NML, (int)blockIdx.x - NML);
                int g0; { FRESH_LANE(); g0 = stage_row_scales<0>(S, (const float*)(ws + WS_RSTD1), lds, tid); }
                Epi1 E{(const LAS float*)(lds + RS_OFF), g0, (bf16*)(ws + WS_QF), (bf16*)(ws + WS_KF), (bf16*)(ws + WS_VF), (bf16*)(ws + WS_SGA), ka->in[4], ka->in[5], 0};
                pg8::gemm_phase<Epi1, pg8::StaticOrder, true, true>(lds, g, S, E, wave);
            }
            asm volatile("s_waitcnt vmcnt(0)" ::: "memory");
            __syncthreads();
            { FRESH_LANE(); if (tid == 0) { __builtin_amdgcn_fence(__ATOMIC_RELEASE, "agent"); asm volatile("s_waitcnt vmcnt(0)" ::: "memory"); __hip_atomic_fetch_add(sbar, 1u, __ATOMIC_RELAXED, __HIP_MEMORY_SCOPE_AGENT); } }
        }
        { FRESH_LANE();
          if (tid == 0) { const unsigned want = (unsigned)(G - NML); while (__hip_atomic_load(sbar, __ATOMIC_RELAXED, __HIP_MEMORY_SCOPE_AGENT) < want) __builtin_amdgcn_s_sleep(8);
              __builtin_amdgcn_fence(__ATOMIC_ACQUIRE, "agent"); asm volatile("s_waitcnt vmcnt(0)" ::: "memory"); } }
        __syncthreads();
        unsigned char* ws = kargs()->ws;
        LAS unsigned* shu = (LAS unsigned*)(lds + LDS_BYTES - 64);
        const float thr2 = *(const float*)(ws + WS_CTL + 2048);
        for (;;) {
            __syncthreads();
            { FRESH_LANE(); if (tid == 0) *shu = atomicAdd((unsigned*)(ws + WS_CTL), 1u); }
            __syncthreads();
            const unsigned uu = *shu;
            if (uu >= 2048u) break;
            const int qb = 15 - (int)(uu >> 7), bh = (int)(uu & 127u);
            if (PH & 8) attn_body::attn_unit<40>(bh >> 3, bh & 7, qb, (const attn_body::bf16*)(ws + WS_QF), (const attn_body::bf16*)(ws + WS_KF), (const attn_body::bf16*)(ws + WS_VF), (attn_body::bf16*)(ws + WS_YA), (const float*)(ws + WS_CNEG), (char*)lds_raw, wave, thr2);
        }
    }
    GRID_BAR();

    if (PH & 16) {
        unsigned char* ws = kargs()->ws;
        pg8::StaticOrder S; S.init(M, 1024, G, (int)blockIdx.x);
        { pg8::Gemm g{(const bf16*)(ws + WS_YA), (const bf16*)(ws + WS_BTFO), M, 1024, 512}; EpiGate<0> E{(const bf16*)(ws + WS_SGA), (bf16*)kargs()->out};
          pg8::gemm_phase<EpiGate<0>, pg8::StaticOrder, false, true>(lds, g, S, E, wave); }
        { pg8::Gemm g{(const bf16*)(ws + WS_YB), (const bf16*)(ws + WS_BTMO), M, 1024, 512}; EpiGate<1> E{(const bf16*)(ws + WS_SGB), (bf16*)kargs()->out};
          pg8::gemm_phase<EpiGate<1>, pg8::StaticOrder, false, true>(lds, g, S, E, wave); }
    }
    GRID_BAR();

    if (PH & 32) {
        KArgs ka = kargs(); unsigned char* ws = ka->ws;
        pg8::Gemm g{(const bf16*)ka->out, (const bf16*)(ws + WS_BTO), M, 1024, 1024}; pg8::StaticOrder S; S.init(M, 1024, G, (int)blockIdx.x);
        EpiX1 E{(const bf16*)(ws + WS_XB), (bf16*)(ws + WS_X1B), (float*)(ws + WS_SSP)};
        pg8::gemm_phase<EpiX1, pg8::StaticOrder, false, true>(lds, g, S, E, wave);
    }
    GRID_BAR();

    if (PH & 64) {
        unsigned char* ws = kargs()->ws;
        pg8::Gemm g{(const bf16*)(ws + WS_X1B), (const bf16*)(ws + WS_BTGU), M, NGU, 1024}; pg8::StaticOrder S; S.init(M, NGU, G, (int)blockIdx.x);
        int g0; { FRESH_LANE(); g0 = stage_row_scales<1>(S, (const float*)(ws + WS_SSP), lds, tid); }
        EpiFFN E{(const LAS float*)(lds + RS_OFF), g0, (bf16*)(ws + WS_HMID)};
        pg8::gemm_phase<EpiFFN, pg8::StaticOrder, true, true>(lds, g, S, E, wave);
    }
    GRID_BAR();

    if (PH & 128) {
        KArgs ka = kargs(); unsigned char* ws = ka->ws;
        pg8::Gemm g{(const bf16*)(ws + WS_HMID), (const bf16*)(ws + WS_BTD), M, 1024, FF}; pg8::StaticOrder S; S.init(M, 1024, G, (int)blockIdx.x);
        EpiOut E{(const bf16*)(ws + WS_X1B), ka->out};
        pg8::gemm_phase<EpiOut, pg8::StaticOrder, true, true>(lds, g, S, E, wave);
    }
}

extern "C" void kernel_launch(void* const* d_in, const int* in_sizes, int n_in, void* d_out, int out_size, void* d_ws, size_t ws_size, hipStream_t stream) {
    static int grid = 0;
    if (grid == 0) {
        if (n_in != 18 || ws_size < WS_END) { fprintf(stderr, "kernel_launch: unexpected n_in %d / ws_size %zu\n", n_in, ws_size); grid = -1; return; }
        int dev = 0, cus = 0, per_cu = 0;
        hipGetDevice(&dev); hipDeviceGetAttribute(&cus, hipDeviceAttributeMultiprocessorCount, dev);
        hipFuncSetAttribute((const void*)fwd_megakernel, hipFuncAttributeMaxDynamicSharedMemorySize, LDS_BYTES);
        hipOccupancyMaxActiveBlocksPerMultiprocessor(&per_cu, (const void*)fwd_megakernel, 512, LDS_BYTES);
        (void)hipGetLastError();
        if (per_cu < 1) per_cu = 1;
        grid = cus;
    }
    if (grid < 0) return;
    Args a{};
    for (int i = 0; i < 18; ++i) a.in[i] = (const float*)d_in[i];
    a.out = (float*)d_out; a.ws = (unsigned char*)d_ws;
    void* args[] = {&a};
    hipError_t e = hipLaunchCooperativeKernel((const void*)fwd_megakernel, dim3(grid), dim3(512), args, LDS_BYTES, stream);
    if (e != hipSuccess) fprintf(stderr, "cooperative launch failed: %s (grid %d)\n", hipGetErrorString(e), grid);
}
```

```cpp
#include <hip/hip_runtime.h>
#include <hip/hip_cooperative_groups.h>
#include <cstdio>
#include <cstdint>
#include <cmath>
namespace cg = cooperative_groups;
namespace pg8 {
#define PG8_LAS __attribute__((address_space(3)))
typedef unsigned short bf16_t;
typedef short bf16x8 __attribute__((ext_vector_type(8)));
typedef float f32x4 __attribute__((ext_vector_type(4)));
typedef unsigned u32x4 __attribute__((ext_vector_type(4)));
constexpr int BM = 256, BK = 64, HALF = 128, HTB = HALF * BK * 2  , STAGE_BYTES = 8 * HTB, NXCD = 8, WGM = 8;

__host__ __device__ __forceinline__ int lds_byte(int r, int c) { const int st = (r >> 4) * 2 + (c >> 5), rr = r & 15, cc = c & 31, ob = rr * 64 + cc * 2; return st * 1024 + (ob ^ (((ob >> 9) & 1) << 5)); }
__host__ __device__ __forceinline__ void stage_rc(int b, int& R, int& C) { const int st = b / 1024, sb = b % 1024, swz = sb ^ (((sb >> 9) & 1) << 5); R = (st >> 1) * 16 + swz / 64; C = (st & 1) * 32 + (swz % 64) / 2; }
__host__ __device__ __forceinline__ int perm32(int rho) { const int n = rho >> 4, i = rho & 15; return 8 * (i >> 2) + 4 * n + (i & 3); }

struct Unit { int pm, pn; };
struct Gemm { const bf16_t* A; const bf16_t* Bt; int M, N, K; };

struct StaticOrder {
    int nM, nN, nwg, G, c;
    __host__ __device__ void init(int M, int N, int G_, int c_) { nM = M / BM; nN = N / BM; nwg = nM * nN; G = G_; c = c_; }
    __host__ __device__ bool next(int i, Unit& u) const {
        const long L = (long)i * G + c; if (L >= nwg) return false;
        int wgid = (int)L; { const int q = nwg / NXCD, r = nwg % NXCD, xcd = wgid % NXCD, off = wgid / NXCD; wgid = (xcd < r ? xcd * (q + 1) : r * (q + 1) + (xcd - r) * q) + off; }
        const int nig = WGM * nN, gid = wgid / nig, fm = gid * WGM, gsz = (nM - fm) < WGM ? (nM - fm) : WGM;
        u.pm = fm + ((wgid % nig) % gsz); u.pn = (wgid % nig) / gsz; return true;
    }
    __device__ __forceinline__ void a_ready(const Unit&) const {}
    __device__ __forceinline__ void done(const Unit&) const {}
};

__device__ __forceinline__ unsigned cvt_pk_bf16(float lo, float hi) { unsigned r; asm volatile("s_nop 0\n\tv_cvt_pk_bf16_f32 %0, %1, %2" : "=v"(r) : "v"(lo), "v"(hi)); return r; }
typedef float f32x2 __attribute__((ext_vector_type(2)));
template <class Epi, class Sched, bool ALIGN_EPI = false, bool SP2 = false>
__device__ __forceinline__ void gemm_phase(PG8_LAS unsigned char* lds, const Gemm g, const Sched& S, const Epi& E, const int wid  ) {
    int lane = __builtin_amdgcn_mbcnt_hi(~0u, __builtin_amdgcn_mbcnt_lo(~0u, 0u)); asm volatile("" : "+v"(lane));
    const int tid = wid * 64 + lane, wr = wid >> 2, wc = wid & 3, fr = lane & 15, fq = lane >> 4;
    const int K = g.K, nt = K / BK;
    unsigned voffA[2], voffB[2];
#pragma unroll
    for (int i = 0; i < 2; ++i) { int R, C; stage_rc(tid * 16 + i * 8192, R, C); const int Rb = Epi::PERM ? ((R & ~31) + perm32(R & 31)) : R;
        voffA[i] = (unsigned)(R * K + C) * 2u; voffB[i] = (unsigned)(Rb * K + C) * 2u; }
    const size_t kstep = (size_t)(BK * 2);
    const size_t hstep = (size_t)HALF * K * 2;
    const size_t tstep = 2 * hstep;
    const unsigned ldsw = (unsigned)wid * 1024u;
    const int aoff = lds_byte(wr * 64 + fr, fq * 8), boff = lds_byte(wc * 32 + fr, fq * 8);
#define PG8_SA(b, h) (((b) * 2 + (h)) * HTB)
#define PG8_SB(b, h) ((4 + (b) * 2 + (h)) * HTB)
#define PG8_STAGE(bufoff, gbase, voff) do { _Pragma("unroll") for (int _i = 0; _i < 2; ++_i) \
        __builtin_amdgcn_global_load_lds((const unsigned*)((const char*)(gbase) + (voff)[_i]), (PG8_LAS unsigned*)(lds + (bufoff) + ldsw + _i * 8192), 16, 0, 0); } while (0)
#define PG8_LDA(dst, b, h) do { _Pragma("unroll") for (int m = 0; m < 4; ++m) _Pragma("unroll") for (int k = 0; k < 2; ++k) dst[m][k] = *(const PG8_LAS bf16x8*)(lds + PG8_SA(b, h) + aoff + m * 2048 + k * 1024); } while (0)
#define PG8_LDB(dst, b, h) do { _Pragma("unroll") for (int n = 0; n < 2; ++n) _Pragma("unroll") for (int k = 0; k < 2; ++k) dst[n][k] = *(const PG8_LAS bf16x8*)(lds + PG8_SB(b, h) + boff + n * 2048 + k * 1024); } while (0)
#define PG8_MMA(ai, bj, At, Bt) do { __builtin_amdgcn_s_setprio(1); _Pragma("unroll") for (int m = 0; m < 4; ++m) _Pragma("unroll") for (int n = 0; n < 2; ++n) _Pragma("unroll") for (int k = 0; k < 2; ++k) \
        acc[ai][bj][m][n] = __builtin_amdgcn_mfma_f32_16x16x32_bf16(Bt[n][k], At[m][k], acc[ai][bj][m][n], 0, 0, 0); __builtin_amdgcn_s_setprio(0); } while (0)
#define PG8_WAIT_V(n) asm volatile("s_waitcnt vmcnt(" #n ")" ::: "memory")
#define PG8_WAIT_L(n) asm volatile("s_waitcnt lgkmcnt(" #n ")" ::: "memory")
#define PG8_BAR __builtin_amdgcn_s_barrier()
#define PG8_SCHED __builtin_amdgcn_sched_barrier(0)
    Unit cur, nxt; int ui = 0;
    if (!S.next(0, cur)) return;
    f32x4 acc[2][2][4][2];
#pragma unroll
    for (int a = 0; a < 2; ++a)
#pragma unroll
        for (int b = 0; b < 2; ++b)
#pragma unroll
            for (int m = 0; m < 4; ++m)
#pragma unroll
                for (int n = 0; n < 2; ++n) acc[a][b][m][n] = (f32x4){0.f, 0.f, 0.f, 0.f};
    bf16x8 At[4][2], B0[2][2], B1[2][2];
    const char* cA = (const char*)g.A + (size_t)cur.pm * tstep; const char* cB = (const char*)g.Bt + (size_t)cur.pn * tstep;
    S.a_ready(cur);
    if constexpr (SP2) {
        PG8_STAGE(PG8_SB(0, 0), cB, voffB); PG8_STAGE(PG8_SB(0, 1), cB + hstep, voffB); PG8_STAGE(PG8_SA(0, 0), cA, voffA); PG8_STAGE(PG8_SA(0, 1), cA + hstep, voffA);
        if (wr == 1) PG8_BAR;
        PG8_WAIT_V(2); PG8_BAR;
        PG8_STAGE(PG8_SB(1, 0), cB + kstep, voffB); PG8_STAGE(PG8_SA(1, 0), cA + kstep, voffA); PG8_STAGE(PG8_SB(1, 1), cB + hstep + kstep, voffB);
        PG8_WAIT_V(6); PG8_BAR;
    } else {
        PG8_STAGE(PG8_SB(0, 0), cB, voffB); PG8_STAGE(PG8_SA(0, 0), cA, voffA); PG8_STAGE(PG8_SB(0, 1), cB + hstep, voffB); PG8_STAGE(PG8_SA(0, 1), cA + hstep, voffA);
        if (wr == 1) PG8_BAR;
        PG8_WAIT_V(4); PG8_BAR;
        PG8_STAGE(PG8_SB(1, 0), cB + kstep, voffB); PG8_STAGE(PG8_SA(1, 0), cA + kstep, voffA); PG8_STAGE(PG8_SB(1, 1), cB + hstep + kstep, voffB);
        PG8_WAIT_V(6); PG8_BAR;
    }
    for (;;) {
        const bool has_next = S.next(ui + 1, nxt);
        const char* nA = has_next ? (const char*)g.A + (size_t)nxt.pm * tstep : cA; const char* nB = has_next ? (const char*)g.Bt + (size_t)nxt.pn * tstep : cB;
        for (int t = 0; t < nt; t += 2) {
            const bool last = (t == nt - 2);
            const char* a1 = cA + (size_t)(t + 1) * kstep;
            const char* a2 = last ? nA : cA + (size_t)(t + 2) * kstep; const char* b2 = last ? nB : cB + (size_t)(t + 2) * kstep;
            const char* a3 = a2 + kstep; const char* b3 = b2 + kstep;
            if (last && has_next) S.a_ready(nxt);
            if constexpr (SP2) {
            PG8_LDB(B0, 0, 0); PG8_LDB(B1, 0, 1); PG8_SCHED; PG8_LDA(At, 0, 0); PG8_STAGE(PG8_SA(1, 1), a1 + hstep, voffA);
            PG8_WAIT_V(8); PG8_WAIT_L(0); PG8_BAR; PG8_MMA(0, 0, At, B0); PG8_MMA(0, 1, At, B1); PG8_BAR; PG8_SCHED;
            PG8_LDA(At, 0, 1); PG8_STAGE(PG8_SB(0, 0), b2, voffB); PG8_STAGE(PG8_SB(0, 1), b2 + hstep, voffB); PG8_STAGE(PG8_SA(0, 0), a2, voffA);
            PG8_WAIT_V(8); PG8_WAIT_L(0); PG8_BAR; PG8_MMA(1, 0, At, B0); PG8_MMA(1, 1, At, B1); PG8_BAR; PG8_SCHED;
            PG8_LDB(B0, 1, 0); PG8_LDB(B1, 1, 1); PG8_SCHED; PG8_LDA(At, 1, 0); PG8_STAGE(PG8_SA(0, 1), a2 + hstep, voffA);
            PG8_WAIT_V(8); PG8_WAIT_L(0); PG8_BAR; PG8_MMA(0, 0, At, B0); PG8_MMA(0, 1, At, B1); PG8_BAR; PG8_SCHED;
            PG8_LDA(At, 1, 1); PG8_STAGE(PG8_SB(1, 0), b3, voffB); PG8_STAGE(PG8_SB(1, 1), b3 + hstep, voffB); PG8_STAGE(PG8_SA(1, 0), a3, voffA);
            PG8_WAIT_V(8); PG8_WAIT_L(0); PG8_BAR; PG8_MMA(1, 0, At, B0); PG8_MMA(1, 1, At, B1); PG8_BAR; PG8_SCHED;
            } else {
            PG8_LDB(B0, 0, 0); PG8_SCHED; PG8_LDA(At, 0, 0); PG8_STAGE(PG8_SA(1, 1), a1 + hstep, voffA);
            PG8_WAIT_L(8); PG8_BAR; PG8_WAIT_L(0); PG8_MMA(0, 0, At, B0); PG8_BAR; PG8_SCHED;
            PG8_LDB(B1, 0, 1); PG8_STAGE(PG8_SB(0, 0), b2, voffB);
            PG8_BAR; PG8_WAIT_L(0); PG8_MMA(0, 1, At, B1); PG8_BAR;
            PG8_LDA(At, 0, 1); PG8_STAGE(PG8_SA(0, 0), a2, voffA);
            PG8_BAR; PG8_WAIT_L(0); PG8_MMA(1, 0, At, B0); PG8_BAR; PG8_SCHED;
            PG8_STAGE(PG8_SB(0, 1), b2 + hstep, voffB);
            PG8_WAIT_V(6); PG8_BAR; PG8_MMA(1, 1, At, B1); PG8_BAR;
            PG8_LDB(B0, 1, 0); PG8_SCHED; PG8_LDA(At, 1, 0); PG8_STAGE(PG8_SA(0, 1), a2 + hstep, voffA);
            PG8_WAIT_L(8); PG8_BAR; PG8_WAIT_L(0); PG8_MMA(0, 0, At, B0); PG8_BAR; PG8_SCHED;
            PG8_LDB(B1, 1, 1); PG8_STAGE(PG8_SB(1, 0), b3, voffB);
            PG8_BAR; PG8_WAIT_L(0); PG8_MMA(0, 1, At, B1); PG8_BAR;
            PG8_LDA(At, 1, 1); PG8_STAGE(PG8_SA(1, 0), a3, voffA);
            PG8_BAR; PG8_WAIT_L(0); PG8_MMA(1, 0, At, B0); PG8_BAR; PG8_SCHED;
            PG8_STAGE(PG8_SB(1, 1), b3 + hstep, voffB);
            PG8_WAIT_V(6); PG8_BAR; PG8_MMA(1, 1, At, B1); PG8_BAR;
            }
        }
        if constexpr (ALIGN_EPI) { if (wr == 0) PG8_BAR; }
        if constexpr (!Epi::AFTER_DRAIN) { E(acc, cur, wr, wc, fr, fq); S.done(cur); }
        if (!has_next) break;
#pragma unroll
        for (int a = 0; a < 2; ++a)
#pragma unroll
            for (int b = 0; b < 2; ++b)
#pragma unroll
                for (int m = 0; m < 4; ++m)
#pragma unroll
                    for (int n = 0; n < 2; ++n) acc[a][b][m][n] = (f32x4){0.f, 0.f, 0.f, 0.f};
        cur = nxt; cA = nA; cB = nB; ++ui;
        if constexpr (ALIGN_EPI) { if (wr == 1) PG8_BAR; }
    }
    PG8_WAIT_V(0);
    if constexpr (!ALIGN_EPI) { if (wr == 0) PG8_BAR; }
    PG8_BAR;
    if constexpr (Epi::AFTER_DRAIN) { E.fused(acc, cur, wr, wc, fr, fq, lds, wid, lane); S.done(cur); }
#undef PG8_SA
#undef PG8_SB
#undef PG8_STAGE
#undef PG8_LDA
#undef PG8_LDB
#undef PG8_MMA
#undef PG8_WAIT_V
#undef PG8_WAIT_L
#undef PG8_BAR
#undef PG8_SCHED
}
}
#include <hip/hip_bf16.h>
#include <cmath>
namespace attn_body {
using bf16=__hip_bfloat16;
using bf16x8=__attribute__((ext_vector_type(8)))short;
using s16x4=__attribute__((ext_vector_type(4)))short;
using f32x16=__attribute__((ext_vector_type(16)))float;
using u32x4=__attribute__((ext_vector_type(4)))unsigned;
constexpr int BATCH=16,NHEAD=8,SEQ=4096,D=64,DM=NHEAD*D;
constexpr int NW=8,QBLK=32,QB=QBLK*NW,KVBLK=64,NQB=SEQ/QB;
constexpr int ATTN_PITCH=DM, ATTN_UNIT_ROWS=QB;
__device__ __forceinline__ int crow(int r,int hi){return (r&3)+8*(r>>2)+4*hi;}
#define SBAR() __builtin_amdgcn_sched_barrier(0)
__device__ __forceinline__ void cmask(f32x16&p0,f32x16&p1,int jb,int qrel,int hi){
  const float NEG=-INFINITY; int kb=64*jb+4*hi;
  #pragma unroll
  for(int r=0;r<16;++r){int kv=kb+(r&3)+8*(r>>2); if(kv>qrel)p0[r]=NEG; if(kv+32>qrel)p1[r]=NEG;}
}

constexpr int NSLOT=3, SLOTB=8192;
constexpr int LDS_K=0, LDS_V=NSLOT*SLOTB, LDS_WS=2*NSLOT*SLOTB, LDS_OST=LDS_WS+NW*64*4, LDS_BIAS=LDS_OST+NW*4096, LDS_BYTES=LDS_BIAS+SEQ*4;
constexpr float C2=0.125f*1.4426950408889634f;
__device__ __forceinline__ void glds16(const void*gsrc,unsigned lds_dst){unsigned keep;
  asm volatile("s_mov_b32 %0, m0\n\ts_mov_b32 m0, %2\n\ts_nop 0\n\tglobal_load_lds_dwordx4 %1, off\n\ts_mov_b32 m0, %0":"=&s"(keep):"v"(gsrc),"s"(lds_dst):"memory");}
__device__ __forceinline__ float max3f(float a,float b,float c){float r;asm("v_max3_f32 %0, %1, %2, %3":"=v"(r):"v"(a),"v"(b),"v"(c));return r;}
__device__ __forceinline__ float max2f(float a,float b){float r;asm("v_max_f32_e32 %0, %1, %2":"=v"(r):"v"(a),"v"(b));return r;}
__device__ __forceinline__ float fadd_s(float a,float b){float r;asm("v_add_f32_e32 %0, %1, %2":"=v"(r):"v"(a),"v"(b));return r;}
__device__ __forceinline__ float fsub_s(float a,float b){float r;asm("v_sub_f32_e32 %0, %1, %2":"=v"(r):"v"(a),"v"(b));return r;}
typedef float f32x2_t __attribute__((ext_vector_type(2))); typedef __bf16 bf16x2_t __attribute__((ext_vector_type(2)));
__device__ __forceinline__ unsigned cvtpk_s(float lo,float hi){f32x2_t v={lo,hi};bf16x2_t b=__builtin_convertvector(v,bf16x2_t);return __builtin_bit_cast(unsigned,b);}
#define WAIT_BAR(N) asm volatile("s_waitcnt vmcnt(" #N ") lgkmcnt(0)\n\ts_barrier":::"memory")

__device__ __forceinline__ void qkt(f32x16&p0,f32x16&p1,const char*Kslot,const bf16x8*qr,int r32,int hi){
  const char*kb=Kslot+hi*1024+r32*16;
  #pragma unroll
  for(int d0=0;d0<4;++d0){
    const bf16x8 b0=*reinterpret_cast<const bf16x8*>(kb+d0*2048);
    const bf16x8 b1=*reinterpret_cast<const bf16x8*>(kb+d0*2048+512);
    {p0=__builtin_amdgcn_mfma_f32_32x32x16_bf16(b0,qr[d0],p0,0,0,0);p1=__builtin_amdgcn_mfma_f32_32x32x16_bf16(b1,qr[d0],p1,0,0,0);}}
}
typedef __attribute__((address_space(3))) const char* lds_cptr;
typedef short v4i16_t __attribute__((ext_vector_type(4)));
__device__ __forceinline__ void kload8(bf16x8*kf,lds_cptr kp){
  kf[0]=*(const __attribute__((address_space(3))) bf16x8*)(kp);      kf[1]=*(const __attribute__((address_space(3))) bf16x8*)(kp+512);
  kf[2]=*(const __attribute__((address_space(3))) bf16x8*)(kp+2048); kf[3]=*(const __attribute__((address_space(3))) bf16x8*)(kp+2560);
  kf[4]=*(const __attribute__((address_space(3))) bf16x8*)(kp+4096); kf[5]=*(const __attribute__((address_space(3))) bf16x8*)(kp+4608);
  kf[6]=*(const __attribute__((address_space(3))) bf16x8*)(kp+6144); kf[7]=*(const __attribute__((address_space(3))) bf16x8*)(kp+6656);
}
__device__ __forceinline__ void kload2(bf16x8*kf,lds_cptr kp,int j){ kf[2*j]=*(const __attribute__((address_space(3))) bf16x8*)(kp+j*2048); kf[2*j+1]=*(const __attribute__((address_space(3))) bf16x8*)(kp+j*2048+512); }
__device__ __forceinline__ s16x4 vtr(lds_cptr p){ return __builtin_bit_cast(s16x4,__builtin_amdgcn_ds_read_tr16_b64_v4i16((__attribute__((address_space(3))) v4i16_t*)p)); }
__device__ __forceinline__ float rowmax(const f32x16&p0,const f32x16&p1){
  float a=max3f(p0[0],p0[1],p1[0]),b=max3f(p0[2],p0[3],p1[1]);a=max3f(a,p1[2],p1[3]);
  #pragma unroll
  for(int r=4;r<16;r+=4){a=max3f(a,p0[r],p0[r+1]);b=max3f(b,p0[r+2],p0[r+3]);a=max3f(a,p1[r],p1[r+1]);b=max3f(b,p1[r+2],p1[r+3]);}
  const float m=max2f(a,b);
  auto rr=__builtin_amdgcn_permlane32_swap(__float_as_uint(m),__float_as_uint(m),false,false);
  return max2f(__uint_as_float(rr[0]),__uint_as_float(rr[1]));
}
__device__ __forceinline__ void pv(f32x16*o,int vb,bf16x8 pa0,bf16x8 pa1,bf16x8 pa2,bf16x8 pa3){
  #pragma unroll
  for(int d0=0;d0<2;++d0){s16x4 lo[4],hi[4];
    #pragma unroll
    for(int ks=0;ks<4;++ks){
      asm volatile("ds_read_b64_tr_b16 %0,%1 offset:%c2":"=&v"(lo[ks]):"v"(vb),"i"(d0*4096+ks*1024):"memory");
      asm volatile("ds_read_b64_tr_b16 %0,%1 offset:%c2":"=&v"(hi[ks]):"v"(vb),"i"(d0*4096+ks*1024+512):"memory");}
    asm volatile("s_waitcnt lgkmcnt(0)":::"memory");SBAR();
    #define PK(k) (bf16x8){lo[k][0],lo[k][1],lo[k][2],lo[k][3],hi[k][0],hi[k][1],hi[k][2],hi[k][3]}
    o[d0]=__builtin_amdgcn_mfma_f32_32x32x16_bf16(pa0,PK(0),o[d0],0,0,0);
    o[d0]=__builtin_amdgcn_mfma_f32_32x32x16_bf16(pa1,PK(1),o[d0],0,0,0);
    o[d0]=__builtin_amdgcn_mfma_f32_32x32x16_bf16(pa2,PK(2),o[d0],0,0,0);
    o[d0]=__builtin_amdgcn_mfma_f32_32x32x16_bf16(pa3,PK(3),o[d0],0,0,0);
    #undef PK
  }
}

#ifndef ATTN_STORE16
#define ATTN_STORE16(p,v) (*(u32x4*)(p)=(v))
#endif
template<int THRL> __device__ __forceinline__ void attn_unit(int b,int h,int qb,const bf16*Q,const bf16*__restrict__ K,const bf16*__restrict__ V,bf16*O,const float*__restrict__ cneg,char*shm,const int wid,const float thr2){
  int lane=__builtin_amdgcn_mbcnt_hi(~0u,__builtin_amdgcn_mbcnt_lo(~0u,0u)); asm volatile("":"+v"(lane)); const int tid=wid*64+lane,r32=lane&31,hi=lane>>5;
  const long rowbase=(long)b*SEQ; const int q0=qb*QB;
  const bf16*Qw=Q+(rowbase+q0+wid*QBLK)*DM+h*D;
  const float*cgrow=cneg+((long)(b*NHEAD+h)*SEQ);
  typedef float f32x4b __attribute__((ext_vector_type(4)));
  const int n4=(q0+QB)>>2; f32x4b bl0={0.f,0.f,0.f,0.f},bl1=bl0; { const f32x4b*cg4=(const f32x4b*)cgrow; if(tid<n4)bl0=cg4[tid]; if(tid+512<n4)bl1=cg4[tid+512]; }
  bf16x8 qr[4];
  #pragma unroll
  for(int d0=0;d0<4;++d0)qr[d0]=*reinterpret_cast<const bf16x8*>(&Qw[(long)r32*DM+d0*16+hi*8]);
  int jstart; { const int NT0=(q0+QB)/KVBLK; const float cq=cgrow[q0], ce=cgrow[64*lane+63]; const bool sk=(lane<NT0-4)&&(cq-ce>thr2); jstart=((int)__builtin_popcountll(__ballot(sk)))&~1; }
  const bf16*Kh=K+(rowbase+(long)jstart*KVBLK)*DM+h*D,*Vh=V+(rowbase+(long)jstart*KVBLK)*DM+h*D;
  const unsigned lds0=(unsigned)(uintptr_t)shm;
  float*wsf=(float*)(shm+LDS_WS)+wid*64;
  const bf16*ksrc=Kh+(long)lane*DM+wid*8;
  const bf16*vsrc=Vh+(long)(16*(wid&3)+(lane>>2))*DM+(wid>>2)*32+(lane&3)*8;
  const unsigned kdst=lds0+LDS_K+wid*1024, vdst=lds0+LDS_V+wid*1024;
  #define DMA_K(t,slot) glds16(ksrc+(long)(t)*KVBLK*DM,(unsigned)__builtin_amdgcn_readfirstlane(kdst+(slot)))
  #define DMA_V(t,slot) glds16(vsrc+(long)(t)*KVBLK*DM,(unsigned)__builtin_amdgcn_readfirstlane(vdst+(slot)))
  const int vb0=(int)(lds0+LDS_V)+((lane>>4)&1)*32+(lane&3)*8+(4*hi+((lane&15)>>2))*64;
  const char*Kbase=shm+LDS_K; bf16x8 kf[8];
  const lds_cptr shm3=(lds_cptr)shm; const lds_cptr kp0=shm3+LDS_K+hi*1024+r32*16; const lds_cptr vp0=shm3+LDS_V+((lane>>4)&1)*32+(lane&3)*8+(4*hi+((lane&15)>>2))*64;
  const int NT=(q0+QB)/KVBLK-jstart;
  typedef __attribute__((address_space(3))) float lds_f32;
  lds_f32*const biasa=(lds_f32*)(shm3+LDS_BIAS);
  lds_f32*const biasl=biasa+64*jstart;
  { if(tid<n4)*(__attribute__((address_space(3))) f32x4b*)(biasa+4*tid)=bl0;
    if(tid+512<n4)*(__attribute__((address_space(3))) f32x4b*)(biasa+4*(tid+512))=bl1; }
  #define BIASC(C0_,C1_,t_) do{ const lds_f32*bp_=biasl+64*(t_)+4*hi; \
    _Pragma("unroll") for(int g_=0;g_<4;++g_){ const f32x4b b0_=*(const __attribute__((address_space(3))) f32x4b*)(bp_+8*g_); const f32x4b b1_=*(const __attribute__((address_space(3))) f32x4b*)(bp_+32+8*g_); \
      _Pragma("unroll") for(int e_=0;e_<4;++e_){ C0_[4*g_+e_]=b0_[e_]-mhat; C1_[4*g_+e_]=b1_[e_]-mhat; } } }while(0)
  DMA_K(0,0);DMA_V(0,0);DMA_K(1,SLOTB);
  float mhat=0.f,l_reg=0.f;f32x16 o[2];o[0]=f32x16{};o[1]=f32x16{};
  const int qrel=wid*QBLK+r32;
  #define CMASK(P0,P1,t) do{int jb_=(t)-(NT-4); if(jb_>=0)cmask(P0,P1,jb_,qrel,hi);}while(0)
  bool resc=false;
  #define START(P0,P1) do{ const float rm=rowmax(P0,P1); resc=false; \
    { const float dl=rm; mhat=fadd_s(mhat,dl); \
      _Pragma("unroll") for(int r=0;r<16;++r){P0[r]=fsub_s(P0[r],dl);P1[r]=fsub_s(P1[r],dl);} \
      } \
    _Pragma("unroll") for(int r=0;r<16;++r)P0[r]=__builtin_amdgcn_exp2f(P0[r]); }while(0)
  #define RESC() do{ if(resc){ asm volatile("s_waitcnt lgkmcnt(0)":::"memory"); \
      _Pragma("unroll") for(int d_=0;d_<2;++d_) _Pragma("unroll") for(int r=0;r<16;++r)o[d_][r]*=wsf[crow(r,hi)]; } }while(0)
  f32x16 pA0,pA1,pB0,pB1;
  int sl_prev=0,sl_cur=0,sl_next=SLOTB;
  #define ROT() do{sl_prev=sl_cur;sl_cur=sl_next;sl_next=(sl_next==(NSLOT-1)*SLOTB)?0:sl_next+SLOTB;}while(0)
  DMA_K(2,2*SLOTB);
  WAIT_BAR(3);
  BIASC(pA0,pA1,0); qkt(pA0,pA1,Kbase,qr,r32,hi);asm volatile("s_nop 15\n\ts_nop 7":"+v"(pA0),"+v"(pA1));CMASK(pA0,pA1,0);
  START(pA0,pA1);
  _Pragma("unroll") for(int r=0;r<16;++r)pA1[r]=__builtin_amdgcn_exp2f(pA1[r]);
  WAIT_BAR(0);
  DMA_K(3,0);DMA_V(1,SLOTB);
  ROT();
  kload8(kf,kp0+sl_cur);
  WAIT_BAR(2);
  s16x4 vlo[8],vhi[8]; u32x4 pw0,pw1,pw2,pw3;
  #define PKW(P,B) cvtpk_s(P[B],P[B+1])
  #define PAF(k) __builtin_bit_cast(bf16x8,pw##k)
  #define VFR(i) (bf16x8){vlo[i][0],vlo[i][1],vlo[i][2],vlo[i][3],vhi[i][0],vhi[i][1],vhi[i][2],vhi[i][3]}
  #define PIN(x) asm volatile("":"+v"(x))
  #define MX3(a,b,c) __builtin_fmaxf(__builtin_fmaxf((a),(b)),(c))
  #define GAPA(MF,A0,A1,A2,A3,W0,W1,PW) do{ MF; sacc+=A0; sacc+=A1; sacc+=A2; sacc+=A3; PIN(sacc); W0; W1; PIN(PW); SBAR(); }while(0)
  #define EX(v) __builtin_amdgcn_exp2f(v)
  #define GAPB(MF,X,B) do{ MF; X[B]=EX(X[B]); X[B+1]=EX(X[B+1]); X[B+2]=EX(X[B+2]); X[B+3]=EX(X[B+3]); PIN(X); SBAR(); }while(0)
  #define VRD(i) do{ vlo[i]=vtr(vp_+(((i)>>2)*4096+((i)&3)*1024)); vhi[i]=vtr(vp_+(((i)>>2)*4096+((i)&3)*1024+512)); }while(0)
  #define KRD(G,j) do{ if(G){ kload2(kf,kp0+sl_next,j); SBAR(); } }while(0)
  #define STEP(C0,C1,P0,P1,t,GK,GV,GL,GB) do{ SBAR(); \
    const lds_cptr vp_=vp0+sl_prev; \
    VRD(0); SBAR(); float sacc=(P0[0]+P0[1]); \
    GAPA(C0=__builtin_amdgcn_mfma_f32_32x32x16_bf16(kf[0],qr[0],C0,0,0,0), P0[2],P0[3],P0[4],P0[5],     pw0[0]=PKW(P0,0), pw0[1]=PKW(P0,2), pw0); \
    VRD(4); SBAR(); GAPA(C1=__builtin_amdgcn_mfma_f32_32x32x16_bf16(kf[1],qr[0],C1,0,0,0), P0[6],P0[7],P0[8],P0[9],     pw0[2]=PKW(P0,4), pw0[3]=PKW(P0,6), pw0); \
    VRD(1); SBAR(); GAPA(C0=__builtin_amdgcn_mfma_f32_32x32x16_bf16(kf[2],qr[1],C0,0,0,0),   P0[10],P0[11],P0[12],P0[13], pw1[0]=PKW(P0,8), pw1[1]=PKW(P0,10), pw1); \
    VRD(5); SBAR(); GAPA(C1=__builtin_amdgcn_mfma_f32_32x32x16_bf16(kf[3],qr[1],C1,0,0,0),   P0[14],P0[15],P1[0],P1[1],   pw1[2]=PKW(P0,12),pw1[3]=PKW(P0,14), pw1); \
    VRD(2); SBAR(); GAPA(C0=__builtin_amdgcn_mfma_f32_32x32x16_bf16(kf[4],qr[2],C0,0,0,0),   P1[2],P1[3],P1[4],P1[5],     pw2[0]=PKW(P1,0), pw2[1]=PKW(P1,2), pw2); \
    VRD(6); SBAR(); GAPA(C1=__builtin_amdgcn_mfma_f32_32x32x16_bf16(kf[5],qr[2],C1,0,0,0),   P1[6],P1[7],P1[8],P1[9],     pw2[2]=PKW(P1,4), pw2[3]=PKW(P1,6), pw2); \
    VRD(3); SBAR(); GAPA(C0=__builtin_amdgcn_mfma_f32_32x32x16_bf16(kf[6],qr[3],C0,0,0,0),   P1[10],P1[11],P1[12],P1[13], pw3[0]=PKW(P1,8), pw3[1]=PKW(P1,10), pw3); \
    VRD(7); SBAR(); GAPA(C1=__builtin_amdgcn_mfma_f32_32x32x16_bf16(kf[7],qr[3],C1,0,0,0),   P1[14],P1[15],0.f,0.f,       pw3[2]=PKW(P1,12),pw3[3]=PKW(P1,14), pw3); \
    l_reg+=sacc; \
    if(GK){DMA_K((t)+3,sl_cur);} if(GV){DMA_V((t)+1,sl_next);} \
    CMASK(C0,C1,t); \
    { float a=MX3(C0[0],C0[1],C1[0]),b=MX3(C0[2],C0[3],C1[1]); a=MX3(a,C1[2],C1[3]); \
      _Pragma("unroll") for(int r=4;r<16;r+=4){a=MX3(a,C0[r],C0[r+1]);b=MX3(b,C0[r+2],C0[r+3]);a=MX3(a,C1[r],C1[r+1]);b=MX3(b,C1[r+2],C1[r+3]);} \
      float rm=__builtin_fmaxf(a,b); { auto rr=__builtin_amdgcn_permlane32_swap(__float_as_uint(rm),__float_as_uint(rm),false,false); rm=__builtin_fmaxf(__uint_as_float(rr[0]),__uint_as_float(rr[1])); } \
      resc=false; \
      if(__builtin_expect(__any(rm>(float)THRL),0)){ const float dl=__builtin_fmaxf(rm,0.f); mhat+=dl; \
        _Pragma("unroll") for(int r=0;r<16;++r){C0[r]-=dl;C1[r]-=dl;} \
        const float f=__builtin_amdgcn_exp2f(-dl); l_reg*=f; if(hi==0)wsf[r32]=f; resc=true; } } \
    SBAR(); \
    GAPB(o[0]=__builtin_amdgcn_mfma_f32_32x32x16_bf16(PAF(0),VFR(0),o[0],0,0,0), C0,0); \
    GAPB(o[1]=__builtin_amdgcn_mfma_f32_32x32x16_bf16(PAF(0),VFR(4),o[1],0,0,0), C0,4); \
    KRD(GL,0); GAPB(o[0]=__builtin_amdgcn_mfma_f32_32x32x16_bf16(PAF(1),VFR(1),o[0],0,0,0), C0,8); \
    KRD(GL,1); GAPB(o[1]=__builtin_amdgcn_mfma_f32_32x32x16_bf16(PAF(1),VFR(5),o[1],0,0,0), C0,12); \
    KRD(GL,2); GAPB(o[0]=__builtin_amdgcn_mfma_f32_32x32x16_bf16(PAF(2),VFR(2),o[0],0,0,0), C1,0); \
    KRD(GL,3); GAPB(o[1]=__builtin_amdgcn_mfma_f32_32x32x16_bf16(PAF(2),VFR(6),o[1],0,0,0), C1,4); \
    GAPB(o[0]=__builtin_amdgcn_mfma_f32_32x32x16_bf16(PAF(3),VFR(3),o[0],0,0,0), C1,8); \
    GAPB(o[1]=__builtin_amdgcn_mfma_f32_32x32x16_bf16(PAF(3),VFR(7),o[1],0,0,0), C1,12); \
    if(GB){ BIASC(P0,P1,(t)+1); SBAR(); } \
    }while(0)
  int t=1;
  BIASC(pB0,pB1,1); SBAR();
  #undef CMASK
  #define CMASK(P0,P1,t) do{}while(0)
  for(;t+5<NT;t+=2){
    STEP(pB0,pB1,pA0,pA1,t,true,true,true,true);     WAIT_BAR(2); RESC(); ROT();
    STEP(pA0,pA1,pB0,pB1,t+1,true,true,true,true);   WAIT_BAR(2); RESC(); ROT();
  }
  #undef CMASK
  #define CMASK(P0,P1,t) do{int jb_=(t)-(NT-4); if(jb_>=0)cmask(P0,P1,jb_,qrel,hi);}while(0)
  #define ENDW(tt) do{ if((tt)+3<NT){WAIT_BAR(2);} else if((tt)+2<NT){WAIT_BAR(1);} else {WAIT_BAR(0);} }while(0)
  for(;t+1<NT;t+=2){
    STEP(pB0,pB1,pA0,pA1,t,(t+3<NT),(t+1<NT),(t+1<NT),true);       ENDW(t);   RESC(); ROT();
    STEP(pA0,pA1,pB0,pB1,t+1,(t+4<NT),(t+2<NT),(t+2<NT),true);     ENDW(t+1); RESC(); ROT();
  }
  STEP(pB0,pB1,pA0,pA1,NT-1,false,false,false,false); RESC();
  { float sacc=pB0[0]+pB0[1]; _Pragma("unroll") for(int r=2;r<16;++r)sacc+=pB0[r]; _Pragma("unroll") for(int r=0;r<16;++r)sacc+=pB1[r]; l_reg+=sacc;
    pw0=(u32x4){PKW(pB0,0),PKW(pB0,2),PKW(pB0,4),PKW(pB0,6)};pw1=(u32x4){PKW(pB0,8),PKW(pB0,10),PKW(pB0,12),PKW(pB0,14)};pw2=(u32x4){PKW(pB1,0),PKW(pB1,2),PKW(pB1,4),PKW(pB1,6)};pw3=(u32x4){PKW(pB1,8),PKW(pB1,10),PKW(pB1,12),PKW(pB1,14)};
    SBAR(); pv(o,vb0+sl_cur,PAF(0),PAF(1),PAF(2),PAF(3)); }
  #undef PKW
  #undef PAF
  #undef VFR
  #undef PIN
  #undef MX3
  #undef GAPA
  #undef GAPB
  #undef EX
  #undef VRD
  #undef KRD
  #undef STEP
  #undef ENDW
  {auto rr=__builtin_amdgcn_permlane32_swap(__float_as_uint(l_reg),__float_as_uint(l_reg),false,false);l_reg=__uint_as_float(rr[0])+__uint_as_float(rr[1]);}
  if(hi==0)wsf[32+r32]=l_reg;asm volatile("s_waitcnt lgkmcnt(0)":::"memory");
  float rli[16];
  #pragma unroll
  for(int r=0;r<16;++r)rli[r]=__builtin_amdgcn_rcpf(wsf[32+crow(r,hi)]);
  bf16*Ow=O+(rowbase+q0+wid*QBLK)*DM+h*D;
  { bf16*stg=(bf16*)(shm+LDS_OST)+wid*2048;
    #pragma unroll
    for(int r=0;r<16;++r){const int orow=crow(r,hi);
      #pragma unroll
      for(int d0=0;d0<2;++d0)stg[orow*64+d0*32+r32]=__float2bfloat16(o[d0][r]*rli[r]);}
    asm volatile("s_waitcnt lgkmcnt(0)":::"memory");
    #pragma unroll
    for(int i=0;i<4;++i){const int row=i*8+(lane>>3),ch=lane&7; const u32x4 v=*(const u32x4*)(stg+row*64+ch*8); ATTN_STORE16(Ow+(long)row*DM+ch*8,v);} }
  asm volatile("s_waitcnt lgkmcnt(0)\n\ts_barrier":::"memory");
  #undef DMA_K
  #undef DMA_V
  #undef CMASK
  #undef START
  #undef RESC
  #undef ROT
  #undef BIASC
}
constexpr int ATTN_LDS_BYTES=LDS_BYTES;
#undef SBAR
#undef WAIT_BAR
}

#define LAS __attribute__((address_space(3)))
typedef unsigned short bf16;
typedef float f32x4 __attribute__((ext_vector_type(4)));
typedef unsigned v4u __attribute__((ext_vector_type(4)));
#define LDS_WAIT() asm volatile("s_waitcnt lgkmcnt(0)" ::: "memory")

constexpr int BATCH = 16, SEQ = 4096, DM = 1024, M = BATCH * SEQ, INW = 5648, FF = 2816;
constexpr int N1 = 5632, NGU = 5632;
constexpr float EPS = 1e-6f;
constexpr float LOG2E = 1.4426950408889634f, C2 = 0.125f * LOG2E;
constexpr int LDS_BYTES = 155648;
#ifndef PHMASK
#define PHMASK 255
#endif
constexpr int PH = PHMASK;
#ifndef P2REP
#define P2REP 1
#endif
#ifndef MLREP
#define MLREP 1
#endif

constexpr size_t MiB = (size_t)1 << 20;
constexpr size_t WS_BT1 = 0, WS_BTGU = 11 * MiB, WS_BTD = 22 * MiB, WS_BTO = 55 * MiB / 2, WS_BTFO = 59 * MiB / 2, WS_BTMO = 61 * MiB / 2;
constexpr size_t WS_XB = 32 * MiB, WS_MERGED = WS_XB;
constexpr size_t WS_QF = 160 * MiB, WS_KF = 224 * MiB, WS_VF = 288 * MiB, WS_MQ = 352 * MiB, WS_MK = 416 * MiB, WS_MV = 480 * MiB, WS_SOB = 544 * MiB;
constexpr size_t WS_HMID = 160 * MiB;
constexpr size_t WS_SGA = 608 * MiB, WS_SGB = 736 * MiB, WS_X1B = WS_SGA;
constexpr size_t WS_YA = 864 * MiB, WS_YB = 928 * MiB;
constexpr size_t WS_SM = 992 * MiB;
constexpr size_t WS_RSTD1 = WS_SM, WS_LFA = WS_SM + 1 * MiB, WS_LI = WS_SM + 3 * MiB, WS_LFB = WS_SM + 4 * MiB, WS_CNEG = WS_SM + 5 * MiB, WS_SSP = WS_SM + 8 * MiB, WS_CTL = WS_SM + 12 * MiB;
constexpr size_t WS_END = 1024 * MiB;

__device__ __forceinline__ unsigned f2bf(float f) { unsigned u = __builtin_bit_cast(unsigned, f); return (u + 0x7fffu + ((u >> 16) & 1u)) >> 16; }
__device__ __forceinline__ unsigned pk2(float lo, float hi) { return f2bf(lo) | (f2bf(hi) << 16); }
__device__ __forceinline__ float bf2f(bf16 b) { return __builtin_bit_cast(float, (unsigned)b << 16); }
__device__ __forceinline__ float bflo(unsigned w) { return __builtin_bit_cast(float, w << 16); }
__device__ __forceinline__ float bfhi(unsigned w) { return __builtin_bit_cast(float, w & 0xffff0000u); }
__device__ __forceinline__ float wave_sum(float v) {
#pragma unroll
    for (int o = 1; o < 64; o <<= 1) v += __shfl_xor(v, o);
    return v;
}
__device__ __forceinline__ float sigmoidf_(float x) { return __builtin_amdgcn_rcpf(1.0f + __expf(-x)); }
__device__ __forceinline__ float logsigf_(float z) { return fminf(z, 0.f) - log1pf(expf(-fabsf(z))); }
__device__ __forceinline__ v4u pack8(f32x4 a, f32x4 b) { v4u w; w.x = pg8::cvt_pk_bf16(a[0], a[1]); w.y = pg8::cvt_pk_bf16(a[2], a[3]); w.z = pg8::cvt_pk_bf16(b[0], b[1]); w.w = pg8::cvt_pk_bf16(b[2], b[3]); return w; }
__device__ __forceinline__ float dot4(f32x4 a, f32x4 b) { return (a[0] * b[0] + a[1] * b[1]) + (a[2] * b[2] + a[3] * b[3]); }

struct Args { const float* in[18]; float* out; unsigned char* ws; };
typedef const __attribute__((address_space(4))) Args* KArgs;
__device__ __forceinline__ KArgs kargs() { KArgs p = (KArgs)__builtin_amdgcn_kernarg_segment_ptr(); asm volatile("" : "+s"(p)); return p; }

constexpr size_t WS_BAR = WS_CTL + 65536;
#define XB_TMO      128
#define XB_XCNT(j)  (256  + 64 * (j))
#define XB_XSUB(j)  (1280 + 64 * (j))
#define XB_XGEN(j)  (2304 + 64 * (j))
#define XB_TOP      3328
#define XB_TOPGEN   3392
#define XCD_BAR_WORDS 3456
#define XB_SPIN_CAP (1u << 18)

__device__ __forceinline__ unsigned xb_ld(unsigned* p)              { return __hip_atomic_load(p, __ATOMIC_RELAXED, __HIP_MEMORY_SCOPE_AGENT); }
__device__ __forceinline__ unsigned xb_add(unsigned* p, unsigned v) { return __hip_atomic_fetch_add(p, v, __ATOMIC_RELAXED, __HIP_MEMORY_SCOPE_AGENT); }
__device__ __forceinline__ unsigned xb_xcc_id() { return (unsigned)__builtin_amdgcn_s_getreg((3 << 11) | 20) & 0xFu; }
#define XB_SPIN(cond, bar) do { unsigned _sp = 0; while (cond) { __builtin_amdgcn_s_sleep(1); \
    if ((++_sp & 255u) == 0u) { if (xb_ld(&(bar)[XB_TMO])) break; if (_sp > XB_SPIN_CAP) { atomicAdd(&(bar)[XB_TMO], 1u); break; } } } } while (0)

struct XcdBarrier {
    unsigned* bar; unsigned x;
    volatile LAS unsigned* st;
};

__device__ __forceinline__ XcdBarrier xcd_barrier_post(unsigned* bar, volatile LAS unsigned* st) {
    XcdBarrier b; b.bar = bar; b.x = xb_xcc_id(); b.st = st;
    if (threadIdx.x == 0) (void)xb_add(&bar[XB_XCNT(b.x)], 1u);
    return b;
}
__device__ __forceinline__ void xcd_barrier_complete(unsigned* bar, unsigned x, unsigned& nloc, unsigned& nx) {
    const unsigned G = gridDim.x * gridDim.y * gridDim.z;
    unsigned sum, cnt, mine, sp = 0u;
    for (;;) {
        sum = 0u; cnt = 0u; mine = 0u;
#pragma unroll
        for (unsigned j = 0; j < 16; ++j) { const unsigned c = xb_ld(&bar[XB_XCNT(j)]); sum += c; cnt += (c > 0u) ? 1u : 0u; mine = (j == x) ? c : mine; }
        if (sum == G) break;
        __builtin_amdgcn_s_sleep(1);
        if ((++sp & 255u) == 0u) { if (xb_ld(&bar[XB_TMO])) break; if (sp > XB_SPIN_CAP) { atomicAdd(&bar[XB_TMO], 1u); break; } }
    }
    nloc = mine > 0u ? mine : 1u; nx = cnt > 0u ? cnt : 1u;
}

__device__ __forceinline__ void xcd_barrier(const XcdBarrier& b) {
    asm volatile("s_waitcnt vmcnt(0)" ::: "memory");
    __syncthreads();
    if (threadIdx.x == 0) {
        unsigned* bar = b.bar;
        __builtin_amdgcn_s_waitcnt(0);
        unsigned nloc = b.st[0], nx = b.st[1];
        if (nloc == 0u) { xcd_barrier_complete(bar, b.x, nloc, nx); b.st[0] = nloc; b.st[1] = nx; }
        const unsigned old = xb_add(&bar[XB_XSUB(b.x)], 1u);
        const unsigned gen = old / nloc;
        if (old + 1u == (gen + 1u) * nloc) {
            __builtin_amdgcn_fence(__ATOMIC_RELEASE, "agent");
            asm volatile("s_waitcnt vmcnt(0)" ::: "memory");
            const unsigned og = xb_add(&bar[XB_TOP], 1u);
            const unsigned tg = og / nx;
            if (og + 1u == (tg + 1u) * nx) xb_add(&bar[XB_TOPGEN], 1u);
            else XB_SPIN(xb_ld(&bar[XB_TOPGEN]) == tg, bar);
            __builtin_amdgcn_fence(__ATOMIC_ACQUIRE, "agent");
            xb_add(&bar[XB_XGEN(b.x)], 1u);
            asm volatile("s_waitcnt vmcnt(0)" ::: "memory");
        } else {
            XB_SPIN(xb_ld(&bar[XB_XGEN(b.x)]) == gen, bar);
            __builtin_amdgcn_fence(__ATOMIC_ACQUIRE, "agent");
            asm volatile("s_waitcnt vmcnt(0)" ::: "memory");
        }
    }
    __syncthreads();
}

struct Epi1 {
    static constexpr bool PERM = true, AFTER_DRAIN = false;
    const LAS float* rsl; int g0;     bf16* qf; bf16* kf; bf16* vf5; bf16* sg2; const float* gq; const float* gk; int pn_off;
    __device__ __forceinline__ void operator()(const f32x4 (&acc)[2][2][4][2], const pg8::Unit& u, int wr, int wc, int fr, int fq) const {
        const int pn = u.pn + pn_off; const int row0 = u.pm * 256 + wr * 64 + fr;
        const LAS float* rsb = rsl + ((u.pm >> 3) - g0) * 256 + wr * 64 + fr;
        if (pn < 4) {
            bf16* O = pn < 2 ? qf : kf; const LAS float* g = rsl + 6 * 256 + (pn < 2 ? 0 : 64); const float post = pn < 2 ? C2 : 1.f;
            const int head = 4 * (pn & 1) + wc;
            f32x4 gv[2][2];
#pragma unroll
            for (int bj = 0; bj < 2; ++bj)
#pragma unroll
                for (int n = 0; n < 2; ++n) gv[bj][n] = *(const LAS f32x4*)(g + 32 * bj + 8 * fq + 4 * n);
#pragma unroll
            for (int ai = 0; ai < 2; ++ai)
#pragma unroll
                for (int m = 0; m < 4; ++m) {
                    const int row = row0 + ai * 128 + m * 16; const float rs = rsb[ai * 128 + m * 16];
                    f32x4 v[2][2]; float ss = 0.f;
#pragma unroll
                    for (int bj = 0; bj < 2; ++bj)
#pragma unroll
                        for (int n = 0; n < 2; ++n) { v[bj][n] = acc[ai][bj][m][n] * rs; ss += dot4(v[bj][n], v[bj][n]); }
                    ss += __shfl_xor(ss, 16); ss += __shfl_xor(ss, 32);
                    const float r = post * __builtin_amdgcn_rsqf(ss * (1.0f / 64.0f) + EPS);
#pragma unroll
                    for (int bj = 0; bj < 2; ++bj) {
                        const f32x4 a = v[bj][0] * gv[bj][0] * r, b = v[bj][1] * gv[bj][1] * r;
                        *(v4u*)(O + (size_t)row * 512 + head * 64 + 32 * bj + 8 * fq) = pack8(a, b);
                    }
                }
        } else if (pn < 6 || pn >= 14) {
            const int s = pn < 6 ? pn - 4 : pn - 12; bf16* O = vf5 + (size_t)(s >> 1) * ((size_t)M * 512); const int col0 = (s & 1) * 256 + wc * 32 + 8 * fq; const bool sig = pn >= 20;
#pragma unroll
            for (int ai = 0; ai < 2; ++ai)
#pragma unroll
                for (int m = 0; m < 4; ++m) {
                    const int row = row0 + ai * 128 + m * 16; const float rs = rsb[ai * 128 + m * 16];
#pragma unroll
                    for (int bj = 0; bj < 2; ++bj) {
                        f32x4 a = acc[ai][bj][m][0] * rs, b = acc[ai][bj][m][1] * rs;
                        if (sig) {
#pragma unroll
                            for (int e = 0; e < 4; ++e) { a[e] = sigmoidf_(a[e]); b[e] = sigmoidf_(b[e]); }
                        }
                        *(v4u*)(O + (size_t)row * 512 + col0 + bj * 128) = pack8(a, b);
                    }
                }
        } else {
            const int s = pn - 6; bf16* O = sg2 + (size_t)(s >> 2) * ((size_t)M * 1024); const int col0 = (s & 3) * 256 + wc * 32 + 8 * fq;
#pragma unroll
            for (int ai = 0; ai < 2; ++ai)
#pragma unroll
                for (int m = 0; m < 4; ++m) {
                    const int row = row0 + ai * 128 + m * 16; const float rs = rsb[ai * 128 + m * 16];
#pragma unroll
                    for (int bj = 0; bj < 2; ++bj) {
                        f32x4 a = acc[ai][bj][m][0] * rs, b = acc[ai][bj][m][1] * rs;
#pragma unroll
                        for (int e = 0; e < 4; ++e) { a[e] = sigmoidf_(a[e]); b[e] = sigmoidf_(b[e]); }
                        *(v4u*)(O + (size_t)row * 1024 + col0 + bj * 128) = pack8(a, b);
                    }
                }
        }
    }
};

template <int PASS> struct EpiGate {
    static constexpr bool PERM = true, AFTER_DRAIN = false;
    const bf16* sg; bf16* mg;
    __device__ __forceinline__ void operator()(const f32x4 (&acc)[2][2][4][2], const pg8::Unit& u, int wr, int wc, int fr, int fq) const {
        const int row0 = u.pm * 256 + wr * 64 + fr; const int col0 = u.pn * 256 + wc * 32 + 8 * fq;
#pragma unroll
        for (int ai = 0; ai < 2; ++ai) {
            v4u gv[4][2], pv[4][2];
#pragma unroll
            for (int m = 0; m < 4; ++m)
#pragma unroll
                for (int bj = 0; bj < 2; ++bj) { const size_t off = (size_t)(row0 + ai * 128 + m * 16) * 1024 + col0 + bj * 128; gv[m][bj] = *(const v4u*)(sg + off); if (PASS == 1) pv[m][bj] = *(const v4u*)(mg + off); }
            asm volatile("" ::: "memory");
#pragma unroll
            for (int m = 0; m < 4; ++m)
#pragma unroll
                for (int bj = 0; bj < 2; ++bj) {
                    const size_t off = (size_t)(row0 + ai * 128 + m * 16) * 1024 + col0 + bj * 128;
                    const v4u g = gv[m][bj];
                    f32x4 a = acc[ai][bj][m][0], b = acc[ai][bj][m][1];
                    a[0] *= bflo(g.x); a[1] *= bfhi(g.x); a[2] *= bflo(g.y); a[3] *= bfhi(g.y);
                    b[0] *= bflo(g.z); b[1] *= bfhi(g.z); b[2] *= bflo(g.w); b[3] *= bfhi(g.w);
                    if (PASS == 1) {
                        const v4u p = pv[m][bj];
                        a[0] += bflo(p.x); a[1] += bfhi(p.x); a[2] += bflo(p.y); a[3] += bfhi(p.y);
                        b[0] += bflo(p.z); b[1] += bfhi(p.z); b[2] += bflo(p.w); b[3] += bfhi(p.w);
                    }
                    *(v4u*)(mg + off) = pack8(a, b);
                }
        }
    }
};

struct EpiX1 {
    static constexpr bool PERM = true, AFTER_DRAIN = false;
    const bf16* xb; bf16* x1b; float* ssp;
    __device__ __forceinline__ void operator()(const f32x4 (&acc)[2][2][4][2], const pg8::Unit& u, int wr, int wc, int fr, int fq) const {
        const int row0 = u.pm * 256 + wr * 64 + fr; const int col0 = u.pn * 256 + wc * 32 + 8 * fq;
        v4u xv[2][4][2];
#pragma unroll
        for (int ai = 0; ai < 2; ++ai)
#pragma unroll
            for (int m = 0; m < 4; ++m)
#pragma unroll
                for (int bj = 0; bj < 2; ++bj) xv[ai][m][bj] = *(const v4u*)(xb + (size_t)(row0 + ai * 128 + m * 16) * 1024 + col0 + bj * 128);
        asm volatile("" ::: "memory");
#pragma unroll
        for (int ai = 0; ai < 2; ++ai)
#pragma unroll
            for (int m = 0; m < 4; ++m) {
                const int row = row0 + ai * 128 + m * 16; float ss = 0.f;
#pragma unroll
                for (int bj = 0; bj < 2; ++bj) {
                    const size_t off = (size_t)row * 1024 + col0 + bj * 128; const v4u w = xv[ai][m][bj];
                    const f32x4 r0 = (f32x4){bflo(w.x), bfhi(w.x), bflo(w.y), bfhi(w.y)} + acc[ai][bj][m][0], r1 = (f32x4){bflo(w.z), bfhi(w.z), bflo(w.w), bfhi(w.w)} + acc[ai][bj][m][1];
                    ss += dot4(r0, r0) + dot4(r1, r1);
                    *(v4u*)(x1b + off) = pack8(r0, r1);
                }
                ss += __shfl_xor(ss, 16); ss += __shfl_xor(ss, 32);
                if (fq == 0) ssp[(size_t)row * 16 + u.pn * 4 + wc] = ss;
            }
    }
};

struct EpiFFN {
    static constexpr bool PERM = true, AFTER_DRAIN = false;
    const LAS float* rsl; int g0; bf16* hmid;
    __device__ __forceinline__ void operator()(const f32x4 (&acc)[2][2][4][2], const pg8::Unit& u, int wr, int wc, int fr, int fq) const {
        const int row0 = u.pm * 256 + wr * 64 + fr; const int col0 = u.pn * 128 + wc * 32 + 8 * fq;
        const LAS float* rsb = rsl + ((u.pm >> 3) - g0) * 256 + wr * 64 + fr;
#pragma unroll
        for (int ai = 0; ai < 2; ++ai)
#pragma unroll
            for (int m = 0; m < 4; ++m) {
                const int row = row0 + ai * 128 + m * 16; const float rs = rsb[ai * 128 + m * 16];
                f32x4 h0, h1;
#pragma unroll
                for (int e = 0; e < 4; ++e) {
                    const float g0_ = acc[ai][0][m][0][e] * rs, u0 = acc[ai][1][m][0][e] * rs, g1 = acc[ai][0][m][1][e] * rs, u1 = acc[ai][1][m][1][e] * rs;
                    h0[e] = g0_ * sigmoidf_(g0_) * u0; h1[e] = g1 * sigmoidf_(g1) * u1;
                }
                *(v4u*)(hmid + (size_t)row * FF + col0) = pack8(h0, h1);
            }
    }
};

struct EpiOut {
    static constexpr bool PERM = true, AFTER_DRAIN = false;
    const bf16* x1b; float* out;
    __device__ __forceinline__ void operator()(const f32x4 (&acc)[2][2][4][2], const pg8::Unit& u, int wr, int wc, int fr, int fq) const {
        const int row0 = u.pm * 256 + wr * 64 + fr; const int col0 = u.pn * 256 + wc * 32 + 8 * fq;
        v4u xv[2][4][2];
#pragma unroll
        for (int ai = 0; ai < 2; ++ai)
#pragma unroll
            for (int m = 0; m < 4; ++m)
#pragma unroll
                for (int bj = 0; bj < 2; ++bj) xv[ai][m][bj] = *(const v4u*)(x1b + (size_t)(row0 + ai * 128 + m * 16) * 1024 + col0 + bj * 128);
        asm volatile("" ::: "memory");
#pragma unroll
        for (int ai = 0; ai < 2; ++ai)
#pragma unroll
            for (int m = 0; m < 4; ++m)
#pragma unroll
                for (int bj = 0; bj < 2; ++bj) {
                    const size_t off = (size_t)(row0 + ai * 128 + m * 16) * 1024 + col0 + bj * 128; const v4u w = xv[ai][m][bj];
                    *(f32x4*)(out + off) = (f32x4){bflo(w.x), bfhi(w.x), bflo(w.y), bfhi(w.y)} + acc[ai][bj][m][0];
                    *(f32x4*)(out + off + 4) = (f32x4){bflo(w.z), bfhi(w.z), bflo(w.w), bfhi(w.w)} + acc[ai][bj][m][1];
                }
    }
};

struct P0Item { const float* W; const float* gs; bf16* WT; int ldw, src, k0, Kd, drow; };
__device__ __forceinline__ void p0_item_issue(const P0Item& d, f32x4 (&wl)[8], float (&gv)[8], int lane) {
#pragma unroll
    for (int i = 0; i < 8; ++i) { const int kk = 8 * i + (lane >> 3); wl[i] = *(const f32x4*)(d.W + (size_t)(d.k0 + kk) * d.ldw + d.src + 4 * (lane & 7)); gv[i] = d.gs ? d.gs[d.k0 + kk] : 1.0f; }
}
__device__ __forceinline__ void p0_item_finish(const P0Item& d, const f32x4 (&wl)[8], const float (&gv)[8], LAS float* scr, int lane) {
#pragma unroll
    for (int i = 0; i < 8; ++i) { const int kk = 8 * i + (lane >> 3); const f32x4 w = wl[i] * gv[i];
        LAS float* q = scr + kk * 33 + 4 * (lane & 7); q[0] = w[0]; q[1] = w[1]; q[2] = w[2]; q[3] = w[3]; }
    LDS_WAIT(); asm volatile("" ::: "memory");
    const int c = lane & 7;
#pragma unroll
    for (int j = 0; j < 4; ++j) { const int n = (lane >> 3) + 8 * j; const LAS float* s = scr + (8 * c) * 33 + n;
        v4u o; o.x = pk2(s[0 * 33], s[1 * 33]); o.y = pk2(s[2 * 33], s[3 * 33]); o.z = pk2(s[4 * 33], s[5 * 33]); o.w = pk2(s[6 * 33], s[7 * 33]);
        *(v4u*)(d.WT + (size_t)(d.drow + n) * d.Kd + d.k0 + 8 * c) = o; }
    LDS_WAIT(); asm volatile("" ::: "memory");
}
__device__ __forceinline__ P0Item p0_decode(KArgs a, unsigned char* ws, int it) {
    constexpr int IT_1 = 16 * 176, IT_FO = 8 * 32, IT_MO = 8 * 32, IT_O = 16 * 32, IT_GU = 16 * 176;
    P0Item d; int r = it;
    if (r < IT_1) { const int kb = r / 176, grp = r % 176, pn = grp >> 3, g8 = grp & 7; int src;
        if (pn < 4) src = (pn < 2 ? 0 : 512) + (4 * (pn & 1) + (g8 & 3)) * 64 + 32 * (g8 >> 2);
        else if (pn < 6) src = 1024 + (pn - 4) * 256 + 32 * g8;
        else if (pn < 14) src = 3600 + (pn - 6) * 256 + 32 * g8;
        else if (pn < 20) src = 1544 + (pn - 14) * 256 + 32 * g8;
        else src = 3088 + (pn - 20) * 256 + 32 * g8;
        d.W = a->in[2]; d.gs = a->in[1]; d.WT = (bf16*)(ws + WS_BT1); d.ldw = INW; d.src = src; d.k0 = 64 * kb; d.Kd = 1024; d.drow = 32 * grp; return d; }
    r -= IT_1;
    if (r < IT_FO) { const int kb = r / 32, grp = r % 32; d.W = a->in[11]; d.gs = nullptr; d.WT = (bf16*)(ws + WS_BTFO); d.ldw = 1024; d.src = 32 * grp; d.k0 = 64 * kb; d.Kd = 512; d.drow = 32 * grp; return d; }
    r -= IT_FO;
    if (r < IT_MO) { const int kb = r / 32, grp = r % 32; d.W = a->in[12]; d.gs = nullptr; d.WT = (bf16*)(ws + WS_BTMO); d.ldw = 1024; d.src = 32 * grp; d.k0 = 64 * kb; d.Kd = 512; d.drow = 32 * grp; return d; }
    r -= IT_MO;
    if (r < IT_O) { const int kb = r / 32, grp = r % 32; d.W = a->in[13]; d.gs = nullptr; d.WT = (bf16*)(ws + WS_BTO); d.ldw = 1024; d.src = 32 * grp; d.k0 = 64 * kb; d.Kd = 1024; d.drow = 32 * grp; return d; }
    r -= IT_O;
    if (r < IT_GU) { const int kb = r / 176, grp = r % 176, pn = grp >> 3, g8 = grp & 7;
        d.W = g8 < 4 ? a->in[15] : a->in[16]; d.gs = a->in[14]; d.WT = (bf16*)(ws + WS_BTGU); d.ldw = FF; d.src = 128 * pn + 32 * (g8 & 3); d.k0 = 64 * kb; d.Kd = 1024; d.drow = 32 * grp; return d; }
    r -= IT_GU;
    { const int kb = r / 32, grp = r % 32; d.W = a->in[17]; d.gs = nullptr; d.WT = (bf16*)(ws + WS_BTD); d.ldw = 1024; d.src = 32 * grp; d.k0 = 64 * kb; d.Kd = FF; d.drow = 32 * grp; }
    return d;
}

__device__ __forceinline__ void p0_phase(KArgs a, LAS unsigned char* lds, int tid, int lane, int wave) {
    unsigned char* ws = a->ws;
    const float* x = a->in[0]; const float* g_mix = a->in[1]; const float* w_in = a->in[2];
    const int G = gridDim.x, gw = blockIdx.x * 8 + wave, NGW = G * 8;
    LAS float* scr = (LAS float*)(lds + wave * 8704);
    LAS float* wgs = (LAS float*)(lds + 69632);
    if (blockIdx.x == 0 && tid < 8) ((unsigned*)(ws + WS_CTL))[64 * tid] = 0u;
    if (blockIdx.x == 0) for (int i = tid; i < XCD_BAR_WORDS; i += 512) ((unsigned*)(ws + WS_BAR))[i] = 0u;
    if (blockIdx.x == 0 && wave == 1) {
        float gq = fabsf(a->in[4][lane]), gk = fabsf(a->in[5][lane]);
#pragma unroll
        for (int o = 1; o < 64; o <<= 1) { gq = fmaxf(gq, __shfl_xor(gq, o)); gk = fmaxf(gk, __shfl_xor(gk, o)); }
        if (lane == 0) *(float*)(ws + WS_CTL + 2048) = 2.0f * (8.0f * LOG2E * 1.02f * gq * gk) + 40.0f;
    }
#pragma unroll
    for (int i = 0; i < 8; ++i) { const int idx = tid + 512 * i, q = idx & 3, k = idx >> 2; const int col = (q < 2 ? 1536 : 3080) + 4 * (q & 1);
        const f32x4 w = *(const f32x4*)(w_in + (size_t)k * INW + col) * g_mix[k]; const int c0 = 4 * q;
        wgs[(c0 + 0) * 1024 + k] = w[0]; wgs[(c0 + 1) * 1024 + k] = w[1]; wgs[(c0 + 2) * 1024 + k] = w[2]; wgs[(c0 + 3) * 1024 + k] = w[3]; }
    constexpr int NITEMS = 16 * 176 + 8 * 32 + 8 * 32 + 16 * 32 + 16 * 176 + 44 * 32;
    __syncthreads();
    bf16* xb = (bf16*)(ws + WS_XB); float* rstd1 = (float*)(ws + WS_RSTD1);
    float* lfa = (float*)(ws + WS_LFA); float* li = (float*)(ws + WS_LI); float* lfb = (float*)(ws + WS_LFB);
    const int npair = (M / NGW) >> 1;
    f32x4 nA[4], nB[4], n2A[4], n2B[4];
    { const f32x4* xa = (const f32x4*)(x + (size_t)gw * 1024) + lane; const f32x4* xb_ = (const f32x4*)(x + (size_t)(gw + NGW) * 1024) + lane;
#pragma unroll
      for (int j = 0; j < 4; ++j) { nA[j] = xa[64 * j]; nB[j] = xb_[64 * j]; }
      const f32x4* xc = (const f32x4*)(x + (size_t)(gw + 2 * NGW) * 1024) + lane; const f32x4* xd = (const f32x4*)(x + (size_t)(gw + 3 * NGW) * 1024) + lane;
#pragma unroll
      for (int j = 0; j < 4; ++j) { n2A[j] = (f32x4){0.f, 0.f, 0.f, 0.f}; n2B[j] = n2A[j]; if (npair > 1) { n2A[j] = xc[64 * j]; n2B[j] = xd[64 * j]; } } }
    const int item_every = npair >= 4 ? (npair >> 2) : 1;
    for (int p = 0; p < npair; ++p) {
        const int rowA = gw + (2 * p) * NGW, rowB = rowA + NGW;
        const int itx = gw + (p / item_every) * NGW; const bool do_item = (p % item_every) == 0 && itx < NITEMS;
        P0Item itd{}; f32x4 wl[8]; float gvv[8];
        if (do_item) { itd = p0_decode(a, ws, itx); p0_item_issue(itd, wl, gvv, lane); }
        f32x4 vA[4], vB[4];
#pragma unroll
        for (int j = 0; j < 4; ++j) { vA[j] = nA[j]; vB[j] = nB[j]; nA[j] = n2A[j]; nB[j] = n2B[j]; }
        if (p + 2 < npair) { const f32x4* xa = (const f32x4*)(x + (size_t)(rowA + 4 * NGW) * 1024) + lane; const f32x4* xb_ = (const f32x4*)(x + (size_t)(rowB + 4 * NGW) * 1024) + lane;
#pragma unroll
            for (int j = 0; j < 4; ++j) { n2A[j] = xa[64 * j]; n2B[j] = xb_[64 * j]; } }
        float ssA = 0.f, ssB = 0.f;
#pragma unroll
        for (int j = 0; j < 4; ++j) { ssA += dot4(vA[j], vA[j]); ssB += dot4(vB[j], vB[j]); }
        { unsigned long long* oA = (unsigned long long*)(xb + (size_t)rowA * 1024) + lane; unsigned long long* oB = (unsigned long long*)(xb + (size_t)rowB * 1024) + lane;
#pragma unroll
          for (int j = 0; j < 4; ++j) { oA[64 * j] = (unsigned long long)pk2(vA[j][0], vA[j][1]) | ((unsigned long long)pk2(vA[j][2], vA[j][3]) << 32);
                                        oB[64 * j] = (unsigned long long)pk2(vB[j][0], vB[j][1]) | ((unsigned long long)pk2(vB[j][2], vB[j][3]) << 32); } }
        float acA[16], acB[16];
#pragma unroll
        for (int c = 0; c < 16; ++c) { float sA = 0.f, sB = 0.f;
#pragma unroll
            for (int j = 0; j < 4; ++j) { const f32x4 w = *(const LAS f32x4*)(wgs + c * 1024 + 256 * j + 4 * lane); sA += dot4(vA[j], w); sB += dot4(vB[j], w); }
            acA[c] = sA; acB[c] = sB; asm volatile("" ::: "memory"); }
#pragma unroll 1
        for (int rr = 0; rr < 2; ++rr) {
            float ac[16];
#pragma unroll
            for (int c = 0; c < 16; ++c) ac[c] = rr ? acB[c] : acA[c];
            const int row = rr ? rowB : rowA;
            const float ss = wave_sum(rr ? ssB : ssA);
            const float rstd = 1.0f / sqrtf(ss * (1.0f / 1024.0f) + EPS);
            { const bool hi = (lane & 32) != 0;
#pragma unroll
              for (int i = 0; i < 8; ++i) { const float keep = hi ? ac[i + 8] : ac[i], send = hi ? ac[i] : ac[i + 8]; ac[i] = keep + __shfl_xor(send, 32); } }
            { const bool hi = (lane & 16) != 0;
#pragma unroll
              for (int i = 0; i < 4; ++i) { const float keep = hi ? ac[i + 4] : ac[i], send = hi ? ac[i] : ac[i + 4]; ac[i] = keep + __shfl_xor(send, 16); } }
            { const bool hi = (lane & 8) != 0;
#pragma unroll
              for (int i = 0; i < 2; ++i) { const float keep = hi ? ac[i + 2] : ac[i], send = hi ? ac[i] : ac[i + 2]; ac[i] = keep + __shfl_xor(send, 8); } }
            { const bool hi = (lane & 4) != 0; const float keep = hi ? ac[1] : ac[0], send = hi ? ac[0] : ac[1]; ac[0] = keep + __shfl_xor(send, 4); }
            ac[0] += __shfl_xor(ac[0], 2); ac[0] += __shfl_xor(ac[0], 1);
            const int c = lane >> 2;
            if ((lane & 3) == 0) {
                const float z = rstd * ac[0]; const int bb = row >> 12, t = row & 4095;
                if (c < 8) lfa[((bb * 8 + c) << 12) + t] = logsigf_(z + a->in[3][c]);
                else if (c < 12) li[((bb * 4 + (c - 8)) << 12) + t] = z + a->in[8][c - 8];
                else lfb[((bb * 4 + (c - 12)) << 12) + t] = logsigf_(z + a->in[9][c - 12]);
            }
            if (lane == 0) rstd1[row] = rstd;
        }
        if (do_item) p0_item_finish(itd, wl, gvv, scr, lane);
    }
    for (int itx = gw + ((npair + item_every - 1) / item_every) * NGW; itx < NITEMS; itx += NGW) {
        const P0Item itd = p0_decode(a, ws, itx); f32x4 wl[8]; float gvv[8]; p0_item_issue(itd, wl, gvv, lane); p0_item_finish(itd, wl, gvv, scr, lane); }
}

__device__ __forceinline__ void cneg_scan(const float* lfa, float* cneg, int bh, LAS unsigned char* lds, int tid, int lane, int wave) {
    const f32x4* src = (const f32x4*)(lfa + (size_t)bh * 4096); f32x4* dst = (f32x4*)(cneg + (size_t)bh * 4096);
    const f32x4 a0 = src[2 * tid], a1 = src[2 * tid + 1];
    float p0 = a0[0], p1 = p0 + a0[1], p2 = p1 + a0[2], p3 = p2 + a0[3], p4 = p3 + a1[0], p5 = p4 + a1[1], p6 = p5 + a1[2], p7 = p6 + a1[3];
    float sc = p7;
#pragma unroll
    for (int o = 1; o < 64; o <<= 1) { const float nb = __shfl_up(sc, o); if (lane >= o) sc += nb; }
    LAS float* wt = (LAS float*)lds;
    if (lane == 63) wt[wave] = sc;
    __syncthreads();
    float off = sc - p7;
    for (int w = 0; w < wave; ++w) off += wt[w];
    f32x4 o0, o1;
    o0[0] = -(off + p0) * LOG2E; o0[1] = -(off + p1) * LOG2E; o0[2] = -(off + p2) * LOG2E; o0[3] = -(off + p3) * LOG2E;
    o1[0] = -(off + p4) * LOG2E; o1[1] = -(off + p5) * LOG2E; o1[2] = -(off + p6) * LOG2E; o1[3] = -(off + p7) * LOG2E;
    dst[2 * tid] = o0; dst[2 * tid + 1] = o1;
    __syncthreads();
}

__device__ __forceinline__ void fox_naive_unit(const bf16* qf, const bf16* kf, const bf16* vf, const float* cneg, bf16* ya, int b, int h, int qb, LAS unsigned char* lds, int tid, int wave) {
    LAS float* Ks = (LAS float*)lds; LAS float* Vs = Ks + 4096; LAS float* Bs = Vs + 4096;
    const int t = qb * 512 + tid; const size_t row = (size_t)b * SEQ + t;
    float q[64], o[64];
    { const v4u* qp = (const v4u*)(qf + row * 512 + h * 64);
#pragma unroll
      for (int i = 0; i < 8; ++i) { const v4u w = qp[i]; q[8 * i + 0] = bflo(w.x); q[8 * i + 1] = bfhi(w.x); q[8 * i + 2] = bflo(w.y); q[8 * i + 3] = bfhi(w.y); q[8 * i + 4] = bflo(w.z); q[8 * i + 5] = bfhi(w.z); q[8 * i + 6] = bflo(w.w); q[8 * i + 7] = bfhi(w.w); } }
#pragma unroll
    for (int d = 0; d < 64; ++d) o[d] = 0.f;
    float mx = -INFINITY, l = 0.f;
    const int ntiles = 8 * (qb + 1); const int wave_tmax = qb * 512 + wave * 64 + 63;
    for (int kt = 0; kt < ntiles; ++kt) {
        __syncthreads();
        { const int key = tid >> 3, ch = tid & 7; const size_t gr = ((size_t)b * SEQ + 64 * kt + key) * 512 + h * 64 + 8 * ch;
          const v4u kw = *(const v4u*)(kf + gr), vw = *(const v4u*)(vf + gr);
          f32x4 k0 = {bflo(kw.x), bfhi(kw.x), bflo(kw.y), bfhi(kw.y)}, k1 = {bflo(kw.z), bfhi(kw.z), bflo(kw.w), bfhi(kw.w)};
          f32x4 v0 = {bflo(vw.x), bfhi(vw.x), bflo(vw.y), bfhi(vw.y)}, v1 = {bflo(vw.z), bfhi(vw.z), bflo(vw.w), bfhi(vw.w)};
          *(LAS f32x4*)(Ks + key * 64 + 8 * ch) = k0; *(LAS f32x4*)(Ks + key * 64 + 8 * ch + 4) = k1;
          *(LAS f32x4*)(Vs + key * 64 + 8 * ch) = v0; *(LAS f32x4*)(Vs + key * 64 + 8 * ch + 4) = v1;
          if (tid < 64) Bs[tid] = cneg[((size_t)(b * 8 + h) << 12) + 64 * kt + tid]; }
        __syncthreads();
        if (64 * kt <= wave_tmax) {
            for (int g = 0; g < 8; ++g) {
                float s[8];
#pragma unroll
                for (int j = 0; j < 8; ++j) { const int key = 8 * g + j; float ac = 0.f;
#pragma unroll
                    for (int d4 = 0; d4 < 16; ++d4) { const f32x4 kk = *(const LAS f32x4*)(Ks + key * 64 + 4 * d4); ac += q[4 * d4] * kk[0] + q[4 * d4 + 1] * kk[1] + q[4 * d4 + 2] * kk[2] + q[4 * d4 + 3] * kk[3]; }
                    ac += Bs[key]; s[j] = (64 * kt + key > t) ? -INFINITY : ac; }
                float gm = s[0];
#pragma unroll
                for (int j = 1; j < 8; ++j) gm = fmaxf(gm, s[j]);
                const float mn = fmaxf(mx, gm);
                if (mn > -INFINITY) {
                    const float alpha = exp2f(mx - mn); mx = mn;
                    float p[8]; float ps = 0.f;
#pragma unroll
                    for (int j = 0; j < 8; ++j) { p[j] = exp2f(s[j] - mn); ps += p[j]; }
                    l = l * alpha + ps;
#pragma unroll
                    for (int d4 = 0; d4 < 16; ++d4) {
                        float o0 = o[4 * d4] * alpha, o1 = o[4 * d4 + 1] * alpha, o2 = o[4 * d4 + 2] * alpha, o3 = o[4 * d4 + 3] * alpha;
#pragma unroll
                        for (int j = 0; j < 8; ++j) { const f32x4 vv = *(const LAS f32x4*)(Vs + (8 * g + j) * 64 + 4 * d4); o0 += p[j] * vv[0]; o1 += p[j] * vv[1]; o2 += p[j] * vv[2]; o3 += p[j] * vv[3]; }
                        o[4 * d4] = o0; o[4 * d4 + 1] = o1; o[4 * d4 + 2] = o2; o[4 * d4 + 3] = o3;
                    }
                }
            }
        }
    }
    const float inv = 1.0f / l;
    v4u* op = (v4u*)(ya + row * 512 + h * 64);
#pragma unroll
    for (int i = 0; i < 8; ++i) { v4u w; w.x = pk2(o[8 * i] * inv, o[8 * i + 1] * inv); w.y = pk2(o[8 * i + 2] * inv, o[8 * i + 3] * inv); w.z = pk2(o[8 * i + 4] * inv, o[8 * i + 5] * inv); w.w = pk2(o[8 * i + 6] * inv, o[8 * i + 7] * inv); op[i] = w; }
}

__device__ __forceinline__ void mlstm_naive_unit(KArgs a, int b, int h, LAS unsigned char* lds, int tid, int lane, int wave) {
    unsigned char* ws = a->ws;
    const bf16* mq = (const bf16*)(ws + WS_MQ); const bf16* mk = (const bf16*)(ws + WS_MK); const bf16* mv = (const bf16*)(ws + WS_MV); const bf16* sob = (const bf16*)(ws + WS_SOB);
    const float* lig = (const float*)(ws + WS_LI) + ((size_t)(b * 4 + h) << 12); const float* lfg = (const float*)(ws + WS_LFB) + ((size_t)(b * 4 + h) << 12);
    bf16* yb = (bf16*)(ws + WS_YB);
    const float* conv_w = a->in[6]; const float* conv_b = a->in[7]; const float* gh = a->in[10];
    LAS float* qs = (LAS float*)lds; LAS float* ks = qs + 64 * 144; LAS float* vs = ks + 64 * 144; LAS float* hs = vs + 64 * 128; LAS float* gl = hs + 64 * 128;
    const int v = tid >> 2, kq = tid & 3;
    float C[32], nn[32];
#pragma unroll
    for (int j = 0; j < 32; ++j) { C[j] = 0.f; nn[j] = 0.f; }
    float mst = 0.f;
    for (int bt = 0; bt < 64; ++bt) {
        const int t0 = bt * 64;
        __syncthreads();
        { const int c = tid & 127, tg = tid >> 7;
#pragma unroll
          for (int which = 0; which < 2; ++which) {
              const bf16* src = which ? mk : mq; LAS float* dst = which ? ks : qs; const int chan = which * 512 + h * 128 + c;
              const float w0 = conv_w[chan], w1 = conv_w[1024 + chan], w2 = conv_w[2048 + chan], w3 = conv_w[3072 + chan], cb = conv_b[chan];
              const float post = which ? 0.08838834764831845f : 1.0f;
              const int ts = t0 + 16 * tg; const bf16* sp = src + ((size_t)b * SEQ) * 512 + h * 128 + c;
              float um3 = ts >= 3 ? bf2f(sp[(size_t)(ts - 3) * 512]) : 0.f, um2 = ts >= 2 ? bf2f(sp[(size_t)(ts - 2) * 512]) : 0.f, um1 = ts >= 1 ? bf2f(sp[(size_t)(ts - 1) * 512]) : 0.f;
              for (int i = 0; i < 16; ++i) { const float uu = bf2f(sp[(size_t)(ts + i) * 512]); const float y = cb + w0 * um3 + w1 * um2 + w2 * um1 + w3 * uu;
                  dst[(16 * tg + i) * 144 + (c >> 5) * 36 + (c & 31)] = y * sigmoidf_(y) * post; um3 = um2; um2 = um1; um1 = uu; }
          }
          for (int i = 0; i < 16; ++i) { const int idx = tid + 512 * i, tok = idx >> 7, cc = idx & 127; vs[tok * 128 + cc] = bf2f(mv[((size_t)b * SEQ + t0 + tok) * 512 + h * 128 + cc]); }
          if (tid < 64) { gl[tid] = lig[t0 + tid]; gl[64 + tid] = lfg[t0 + tid]; } }
        __syncthreads();
        for (int tt = 0; tt < 64; ++tt) {
            const float li_t = gl[tt], lf_t = gl[64 + tt];
            const float mn = fmaxf(lf_t + mst, li_t); const float fdec = __expf(lf_t + mst - mn), iw = __expf(li_t - mn); mst = mn;
            const float ivt = iw * vs[tt * 128 + v];
            float num = 0.f, den = 0.f;
#pragma unroll
            for (int j4 = 0; j4 < 8; ++j4) { const f32x4 kk = *(const LAS f32x4*)(ks + tt * 144 + kq * 36 + 4 * j4), qq = *(const LAS f32x4*)(qs + tt * 144 + kq * 36 + 4 * j4);
#pragma unroll
                for (int e = 0; e < 4; ++e) { const int j = 4 * j4 + e; C[j] = fdec * C[j] + ivt * kk[e]; nn[j] = fdec * nn[j] + iw * kk[e]; num += C[j] * qq[e]; den += nn[j] * qq[e]; } }
            num += __shfl_xor(num, 1); num += __shfl_xor(num, 2); den += __shfl_xor(den, 1); den += __shfl_xor(den, 2);
            const float hv = num / fmaxf(fabsf(den), __expf(-mst));
            if (kq == 0) hs[tt * 128 + v] = hv;
        }
        __syncthreads();
        for (int i = 0; i < 8; ++i) { const int tok = 8 * wave + i; const float x0 = hs[tok * 128 + lane], x1 = hs[tok * 128 + 64 + lane];
            const float mean = wave_sum(x0 + x1) * (1.0f / 128.0f); const float d0 = x0 - mean, d1 = x1 - mean;
            const float var = wave_sum(d0 * d0 + d1 * d1) * (1.0f / 128.0f); const float r = 1.0f / sqrtf(var + EPS);
            const size_t rowo = ((size_t)b * SEQ + t0 + tok) * 512 + h * 128;
            yb[rowo + lane] = (bf16)f2bf(d0 * r * gh[h * 128 + lane] * bf2f(sob[rowo + lane]));
            yb[rowo + 64 + lane] = (bf16)f2bf(d1 * r * gh[h * 128 + 64 + lane] * bf2f(sob[rowo + 64 + lane])); }
    }
}

constexpr size_t WS_GB = WS_SM + 13 * MiB, WS_GG = WS_SM + 14 * MiB, WS_GM = WS_SM + 15 * MiB, WS_MC = WS_SM + 16 * MiB;

__device__ __forceinline__ void mlstm_gate_prepass(const float* li, const float* lfb, float* gb, float* gg, float* gM, float* mc, int bh, LAS unsigned char* lds, int tid) {
    const f32x4* lf4 = (const f32x4*)(lfb + (size_t)bh * 4096); const f32x4* li4 = (const f32x4*)(li + (size_t)bh * 4096);
    const f32x4 f0 = lf4[2 * tid], f1 = lf4[2 * tid + 1], i0 = li4[2 * tid], i1 = li4[2 * tid + 1];
    float bb[8]; bb[0] = f0[0]; bb[1] = bb[0] + f0[1]; bb[2] = bb[1] + f0[2]; bb[3] = bb[2] + f0[3]; bb[4] = bb[3] + f1[0]; bb[5] = bb[4] + f1[1]; bb[6] = bb[5] + f1[2]; bb[7] = bb[6] + f1[3];
    float sc = bb[7];
#pragma unroll
    for (int o = 1; o < 16; o <<= 1) { const float nb = __shfl_up(sc, o, 16); if ((tid & 15) >= o) sc += nb; }
    const float off = sc - bb[7];
    float gv[8], mv[8];
    const float lis[8] = {i0[0], i0[1], i0[2], i0[3], i1[0], i1[1], i1[2], i1[3]};
#pragma unroll
    for (int e = 0; e < 8; ++e) { bb[e] += off; gv[e] = lis[e] - bb[e]; mv[e] = e ? fmaxf(mv[e - 1], gv[e]) : gv[0]; }
    float mx = mv[7];
#pragma unroll
    for (int o = 1; o < 16; o <<= 1) { const float nb = __shfl_up(mx, o, 16); if ((tid & 15) >= o) mx = fmaxf(mx, nb); }
    const float prev = __shfl_up(mx, 1, 16);
    if ((tid & 15) != 0) {
#pragma unroll
        for (int e = 0; e < 8; ++e) mv[e] = fmaxf(mv[e], prev);
    }
    f32x4* gb4 = (f32x4*)(gb + (size_t)bh * 4096); f32x4* gg4 = (f32x4*)(gg + (size_t)bh * 4096); f32x4* gM4 = (f32x4*)(gM + (size_t)bh * 4096);
    gb4[2 * tid] = (f32x4){bb[0], bb[1], bb[2], bb[3]}; gb4[2 * tid + 1] = (f32x4){bb[4], bb[5], bb[6], bb[7]};
    gg4[2 * tid] = (f32x4){gv[0], gv[1], gv[2], gv[3]}; gg4[2 * tid + 1] = (f32x4){gv[4], gv[5], gv[6], gv[7]};
    gM4[2 * tid] = (f32x4){mv[0], mv[1], mv[2], mv[3]}; gM4[2 * tid + 1] = (f32x4){mv[4], mv[5], mv[6], mv[7]};
    LAS float* cl = (LAS float*)lds;
    if ((tid & 15) == 15) { cl[tid >> 4] = bb[7]; cl[32 + (tid >> 4)] = mv[7]; }
    __syncthreads();
    if (tid == 0) { float m = 0.f; for (int c = 0; c < 32; ++c) { mc[bh * 32 + c] = m; m = cl[c] + fmaxf(m, cl[32 + c]); } }
    __syncthreads();
}

namespace ml {
typedef short bf16x8 __attribute__((ext_vector_type(8)));
typedef short s16x4 __attribute__((ext_vector_type(4)));
constexpr int PITCH = 136;
constexpr int TILE_B = 128 * PITCH * 2;
constexpr int O_KS = 0, O_KT = TILE_B, O_VT = 2 * TILE_B, O_CB = 3 * TILE_B, O_SM = 4 * TILE_B;
constexpr int O_GS = O_SM, O_MU = O_SM + 512, O_WI = O_SM + 1024, O_EM = O_SM + 1536, O_WS = O_SM + 2048, O_N = O_SM + 2560, O_NP = O_SM + 3072  , O_GH = O_SM + 5120, O_CW = O_SM + 5632  , O_KW = O_SM + 8192  , O_SC = O_SM + 10752, O_END = O_SM + 10816;
static_assert(O_END <= LDS_BYTES - 64, "mLSTM LDS map");
__device__ __forceinline__ unsigned pkbf(float lo, float hi) { return pg8::cvt_pk_bf16(lo, hi); }
}

__device__ __forceinline__ void mlstm_fast_unit(KArgs a, int b, int h, LAS unsigned char* lds, int tid, int lane, int wave) {
    using namespace ml;
    unsigned char* ws = a->ws;
    const bf16* mq = (const bf16*)(ws + WS_MQ); const bf16* mk = (const bf16*)(ws + WS_MK); const bf16* mv = (const bf16*)(ws + WS_MV); const bf16* sob = (const bf16*)(ws + WS_SOB);
    bf16* yb = (bf16*)(ws + WS_YB);
    const int bh = b * 4 + h;
    const float* gbp = (const float*)(ws + WS_GB) + (size_t)bh * 4096; const float* ggp = (const float*)(ws + WS_GG) + (size_t)bh * 4096; const float* gMp = (const float*)(ws + WS_GM) + (size_t)bh * 4096;
    const float* mcp = (const float*)(ws + WS_MC) + bh * 32;
    const float* conv_w = a->in[6]; const float* conv_b = a->in[7];
    LAS bf16* KS = (LAS bf16*)(lds + O_KS); LAS bf16* KT = (LAS bf16*)(lds + O_KT); LAS bf16* VT = (LAS bf16*)(lds + O_VT); LAS bf16* CB = (LAS bf16*)(lds + O_CB);
    LAS float* gs = (LAS float*)(lds + O_GS); LAS float* mus = (LAS float*)(lds + O_MU); LAS float* wis = (LAS float*)(lds + O_WI); LAS float* ems = (LAS float*)(lds + O_EM); LAS float* wss = (LAS float*)(lds + O_WS);
    LAS float* nst = (LAS float*)(lds + O_N); LAS float* npart = (LAS float*)(lds + O_NP); LAS float* ghs = (LAS float*)(lds + O_GH); LAS float* cws = (LAS float*)(lds + O_CW); LAS float* scal = (LAS float*)(lds + O_SC);
    const int c16 = lane & 15, g = lane >> 4;
    __syncthreads();
    for (int i = tid; i < TILE_B / 4; i += 512) ((LAS unsigned*)CB)[i] = 0u;
    if (tid < 128) { nst[tid] = 0.f; ghs[tid] = a->in[10][h * 128 + tid]; }
    LAS float* kws = (LAS float*)(lds + O_KW);
    for (int i = tid; i < 640; i += 512) { const int tap = i >> 7, ch = i & 127; cws[i] = tap < 4 ? conv_w[tap * 1024 + h * 128 + ch] : conv_b[h * 128 + ch];
        kws[i] = tap < 4 ? conv_w[tap * 1024 + 512 + h * 128 + ch] : conv_b[512 + h * 128 + ch]; }
    const int ch8 = tid & 15, tq = tid >> 4;
    v4u kr[7], vr[4];
#define ML_LOAD_KV(cc) do { const int tb_ = (cc) * 128 + 4 * tq; const size_t ro_ = ((size_t)b * SEQ + tb_) * 512 + h * 128 + 8 * ch8; \
        _Pragma("unroll") for (int r_ = 0; r_ < 7; ++r_) { kr[r_] = (v4u){0u, 0u, 0u, 0u}; if (tb_ - 3 + r_ >= 0) kr[r_] = *(const v4u*)(mk + ro_ + (r_ - 3) * 512); } \
        _Pragma("unroll") for (int r_ = 0; r_ < 4; ++r_) vr[r_] = *(const v4u*)(mv + ro_ + r_ * 512); } while (0)
    v4u qraw[4][4]; float tbM = 0.f, tbB = 0.f, tbG = 0.f, tbL = 0.f, tbm = 0.f;
#define ML_LOAD_Q(J0, cc) do { const int tglob = (cc) * 128 + 16 * wave + c16; const bf16* qp = mq + ((size_t)b * SEQ + tglob) * 512 + h * 128 + 8 * g; \
          _Pragma("unroll") for (int j = (J0); j < (J0) + 2; ++j) { \
              _Pragma("unroll") for (int r = 0; r < 4; ++r) { qraw[j][r] = (v4u){0u, 0u, 0u, 0u}; if (tglob - 3 + r >= 0) qraw[j][r] = *(const v4u*)(qp + (r - 3) * 512 + 32 * j); } } } while (0)
#define ML_LOAD_TB(cc) do { tbm = mcp[(cc)]; tbL = gMp[(cc) * 128 + 127]; if (tid < 128) { tbM = gMp[(cc) * 128 + tid]; tbB = gbp[(cc) * 128 + tid]; tbG = ggp[(cc) * 128 + tid]; } } while (0)
#define ML_BAR() asm volatile("s_waitcnt lgkmcnt(0)\n\ts_barrier" ::: "memory")
    ML_LOAD_TB(0);
    f32x4 Cst[8];
#pragma unroll
    for (int kb = 0; kb < 8; ++kb) Cst[kb] = (f32x4){0.f, 0.f, 0.f, 0.f};
    __syncthreads();

    for (int c = 0; c < 32; ++c) {
        const int t0 = c * 128;
        const size_t rowb = (size_t)b * SEQ + t0;
        ML_LOAD_KV(c); ML_LOAD_Q(0, c);
        {
            unsigned ksw[4][4];
#pragma unroll
            for (int wd = 0; wd < 4; ++wd) {
                float kk[4][2];
                typedef float f32x2_ __attribute__((ext_vector_type(2)));
                const f32x2_ kw0 = *(const LAS f32x2_*)(kws + 8 * ch8 + 2 * wd), kw1 = *(const LAS f32x2_*)(kws + 128 + 8 * ch8 + 2 * wd), kw2 = *(const LAS f32x2_*)(kws + 256 + 8 * ch8 + 2 * wd), kw3 = *(const LAS f32x2_*)(kws + 384 + 8 * ch8 + 2 * wd), kwb = *(const LAS f32x2_*)(kws + 512 + 8 * ch8 + 2 * wd);
#pragma unroll
                for (int hf = 0; hf < 2; ++hf) {
                    const float w0 = kw0[hf], w1 = kw1[hf], w2 = kw2[hf], w3 = kw3[hf], cb = kwb[hf];
                    float u[7];
#pragma unroll
                    for (int r = 0; r < 7; ++r) { const unsigned w = wd == 0 ? kr[r].x : wd == 1 ? kr[r].y : wd == 2 ? kr[r].z : kr[r].w; u[r] = hf ? bfhi(w) : bflo(w); }
#pragma unroll
                    for (int i = 0; i < 4; ++i) { const float y = cb + w0 * u[i] + w1 * u[i + 1] + w2 * u[i + 2] + w3 * u[i + 3]; kk[i][hf] = y * sigmoidf_(y) * 0.08838834764831845f; }
                }
#pragma unroll
                for (int i = 0; i < 4; ++i) ksw[i][wd] = pkbf(kk[i][0], kk[i][1]);
#pragma unroll
                for (int hf = 0; hf < 2; ++hf) { const int row = 8 * ch8 + 2 * wd + hf; const int gr = (tq >> 1) ^ ch8;
                    const unsigned long long kt = (unsigned long long)pkbf(kk[0][hf], kk[1][hf]) | ((unsigned long long)pkbf(kk[2][hf], kk[3][hf]) << 32);
                    *(LAS unsigned long long*)(KT + row * PITCH + 8 * gr + 4 * (tq & 1)) = kt;
                    const unsigned v0 = wd == 0 ? vr[0].x : wd == 1 ? vr[0].y : wd == 2 ? vr[0].z : vr[0].w, v1 = wd == 0 ? vr[1].x : wd == 1 ? vr[1].y : wd == 2 ? vr[1].z : vr[1].w;
                    const unsigned v2 = wd == 0 ? vr[2].x : wd == 1 ? vr[2].y : wd == 2 ? vr[2].z : vr[2].w, v3 = wd == 0 ? vr[3].x : wd == 1 ? vr[3].y : wd == 2 ? vr[3].z : vr[3].w;
                    const unsigned lo = hf ? ((v0 >> 16) | (v1 & 0xffff0000u)) : ((v0 & 0xffffu) | (v1 << 16)), hi = hf ? ((v2 >> 16) | (v3 & 0xffff0000u)) : ((v2 & 0xffffu) | (v3 << 16));
                    *(LAS unsigned long long*)(VT + row * PITCH + 8 * gr + 4 * (tq & 1)) = (unsigned long long)lo | ((unsigned long long)hi << 32); }
                asm volatile("" ::: "memory");
            }
#pragma unroll
            for (int i = 0; i < 4; ++i) *(LAS v4u*)(KS + (4 * tq + i) * PITCH + 8 * ch8) = (v4u){ksw[i][0], ksw[i][1], ksw[i][2], ksw[i][3]};
            asm volatile("" ::: "memory");
            ML_LOAD_Q(2, c);
            if (tid < 128) {
                const float m = tbm, Mt = tbM, bt = tbB, gt = tbG, Ml = tbL;
                const float mu = fmaxf(m, Mt), mul = fmaxf(m, Ml);
                gs[tid] = gt; mus[tid] = mu; wis[tid] = __expf(m - mu); ems[tid] = __expf(-(bt + mu)); wss[tid] = __expf(gt - mul);
                if (tid == 0) scal[0] = __expf(m - mul);
            }
        }
        bf16x8 Qf[4]; float qn = 0.f;
#pragma unroll
        for (int j = 0; j < 4; ++j) {
            unsigned qw[4];
#pragma unroll
            for (int hh = 0; hh < 2; ++hh) {
                f32x4 cw[5];
#pragma unroll
                for (int tp = 0; tp < 5; ++tp) cw[tp] = *(const LAS f32x4*)(cws + tp * 128 + 32 * j + 8 * g + 4 * hh);
                float q4[4];
#pragma unroll
                for (int e4 = 0; e4 < 4; ++e4) {
                    const int wd = 2 * hh + (e4 >> 1);
                    const unsigned w0 = wd == 0 ? qraw[j][0].x : wd == 1 ? qraw[j][0].y : wd == 2 ? qraw[j][0].z : qraw[j][0].w, w1 = wd == 0 ? qraw[j][1].x : wd == 1 ? qraw[j][1].y : wd == 2 ? qraw[j][1].z : qraw[j][1].w;
                    const unsigned w2 = wd == 0 ? qraw[j][2].x : wd == 1 ? qraw[j][2].y : wd == 2 ? qraw[j][2].z : qraw[j][2].w, w3 = wd == 0 ? qraw[j][3].x : wd == 1 ? qraw[j][3].y : wd == 2 ? qraw[j][3].z : qraw[j][3].w;
                    const float u0 = (e4 & 1) ? bfhi(w0) : bflo(w0), u1 = (e4 & 1) ? bfhi(w1) : bflo(w1), u2 = (e4 & 1) ? bfhi(w2) : bflo(w2), u3 = (e4 & 1) ? bfhi(w3) : bflo(w3);
                    const float y = cw[4][e4] + cw[0][e4] * u0 + cw[1][e4] * u1 + cw[2][e4] * u2 + cw[3][e4] * u3;
                    q4[e4] = y * sigmoidf_(y);
                }
                qw[2 * hh] = pkbf(q4[0], q4[1]); qw[2 * hh + 1] = pkbf(q4[2], q4[3]);
                asm volatile("" ::: "memory");
            }
            Qf[j] = __builtin_bit_cast(bf16x8, (v4u){qw[0], qw[1], qw[2], qw[3]});
        }
        ML_BAR();
        if (c + 1 < 32) { ML_LOAD_TB(c + 1); }
        unsigned long long sow[8];
        { const size_t ro = (rowb + 16 * wave + c16) * 512 + h * 128 + 4 * g;
#pragma unroll
          for (int vt = 0; vt < 8; ++vt) sow[vt] = *(const unsigned long long*)(sob + ro + 16 * vt); }
        const int tl = 16 * wave + c16;
        const float mu_t = mus[tl], wi_t = wis[tl], em_t = ems[tl];
        {
#pragma unroll
            for (int j = 0; j < 4; ++j) { const v4u qq = __builtin_bit_cast(v4u, Qf[j]); const LAS float* np = nst + 32 * j + 8 * g;
                const f32x4 n0 = *(const LAS f32x4*)np, n1 = *(const LAS f32x4*)(np + 4);
                qn += bflo(qq.x) * n0[0] + bfhi(qq.x) * n0[1] + bflo(qq.y) * n0[2] + bfhi(qq.y) * n0[3] + bflo(qq.z) * n1[0] + bfhi(qq.z) * n1[1] + bflo(qq.w) * n1[2] + bfhi(qq.w) * n1[3]; }
            qn += __shfl_xor(qn, 16); qn += __shfl_xor(qn, 32);
        }
        f32x4 acc[8];
#pragma unroll
        for (int vt = 0; vt < 8; ++vt) { f32x4 s = {0.f, 0.f, 0.f, 0.f};
#pragma unroll
            for (int j = 0; j < 4; ++j) { const bf16x8 af = *(const LAS bf16x8*)(CB + (16 * vt + c16) * PITCH + 32 * j + 8 * g); s = __builtin_amdgcn_mfma_f32_16x16x32_bf16(af, Qf[j], s, 0, 0, 0); }
            acc[vt] = s * wi_t; }
        float dsum = 0.f;
        for (int jj = 0; jj <= (wave >> 1); ++jj) {
            float pk[2][4];
#pragma unroll
            for (int half = 0; half < 2; ++half) {
                const int st = 2 * jj + half;
                if (st <= wave) {
                    f32x4 s = {0.f, 0.f, 0.f, 0.f};
#pragma unroll
                    for (int j = 0; j < 4; ++j) { const bf16x8 kf = *(const LAS bf16x8*)(KS + (16 * st + c16) * PITCH + 32 * j + 8 * g); s = __builtin_amdgcn_mfma_f32_16x16x32_bf16(kf, Qf[j], s, 0, 0, 0); }
                    const f32x4 gv = *(const LAS f32x4*)(gs + 16 * st + 4 * g);
#pragma unroll
                    for (int i = 0; i < 4; ++i) { float p = s[i] * __expf(fminf(gv[i] - mu_t, 0.f)); if (st == wave && 4 * g + i > c16) p = 0.f; pk[half][i] = p; dsum += p; }
                } else {
#pragma unroll
                    for (int i = 0; i < 4; ++i) pk[half][i] = 0.f;
                }
            }
            v4u pb; pb.x = pkbf(pk[0][0], pk[0][1]); pb.y = pkbf(pk[0][2], pk[0][3]); pb.z = pkbf(pk[1][0], pk[1][1]); pb.w = pkbf(pk[1][2], pk[1][3]);
            const bf16x8 bfr = __builtin_bit_cast(bf16x8, pb);
#pragma unroll
            for (int vt = 0; vt < 8; ++vt) {
                const LAS bf16* vrow = VT + (16 * vt + c16) * PITCH + 4 * (g & 1); const int rsw = 2 * vt + (c16 >> 3), g0 = 4 * jj + (g >> 1);
                const s16x4 lo = *(const LAS s16x4*)(vrow + 8 * (g0 ^ rsw)), hi = *(const LAS s16x4*)(vrow + 8 * ((g0 + 2) ^ rsw));
                const bf16x8 af = (bf16x8){lo[0], lo[1], lo[2], lo[3], hi[0], hi[1], hi[2], hi[3]};
                acc[vt] = __builtin_amdgcn_mfma_f32_16x16x32_bf16(af, bfr, acc[vt], 0, 0, 0);
            }
        }
        dsum += __shfl_xor(dsum, 16); dsum += __shfl_xor(dsum, 32);
        {
            const float den = wi_t * qn + dsum; const float inv = __builtin_amdgcn_rcpf(fmaxf(fabsf(den), em_t));
            float sm = 0.f;
#pragma unroll
            for (int vt = 0; vt < 8; ++vt) { acc[vt] = acc[vt] * inv; sm += (acc[vt][0] + acc[vt][1]) + (acc[vt][2] + acc[vt][3]); }
            sm += __shfl_xor(sm, 16); sm += __shfl_xor(sm, 32);
            const float mean = sm * (1.0f / 128.0f); float sq = 0.f;
#pragma unroll
            for (int vt = 0; vt < 8; ++vt) { acc[vt] = acc[vt] - mean; sq += dot4(acc[vt], acc[vt]); }
            sq += __shfl_xor(sq, 16); sq += __shfl_xor(sq, 32);
            const float r = __builtin_amdgcn_rsqf(sq * (1.0f / 128.0f) + EPS);
            const size_t ro = (rowb + tl) * 512 + h * 128 + 4 * g;
#pragma unroll
            for (int vt = 0; vt < 8; ++vt) {
                const unsigned long long sw = sow[vt]; const unsigned s0 = (unsigned)sw, s1 = (unsigned)(sw >> 32);
                const f32x4 gh4 = *(const LAS f32x4*)(ghs + 16 * vt + 4 * g);
                const float y0 = acc[vt][0] * r * gh4[0] * bflo(s0), y1 = acc[vt][1] * r * gh4[1] * bfhi(s0), y2 = acc[vt][2] * r * gh4[2] * bflo(s1), y3 = acc[vt][3] * r * gh4[3] * bfhi(s1);
                *(unsigned long long*)(yb + ro + 16 * vt) = (unsigned long long)pkbf(y0, y1) | ((unsigned long long)pkbf(y2, y3) << 32);
            }
        }
        ML_BAR();
        const float decay = scal[0];
        {
            bf16x8 Vw[4];
#pragma unroll
            for (int j = 0; j < 4; ++j) {
                const v4u vr_ = *(const LAS v4u*)(VT + (16 * wave + c16) * PITCH + 8 * ((4 * j + g) ^ (2 * wave + (c16 >> 3))));
                const f32x4 w0 = *(const LAS f32x4*)(wss + 32 * j + 8 * g), w1 = *(const LAS f32x4*)(wss + 32 * j + 8 * g + 4);
                v4u o; o.x = pkbf(bflo(vr_.x) * w0[0], bfhi(vr_.x) * w0[1]); o.y = pkbf(bflo(vr_.y) * w0[2], bfhi(vr_.y) * w0[3]); o.z = pkbf(bflo(vr_.z) * w1[0], bfhi(vr_.z) * w1[1]); o.w = pkbf(bflo(vr_.w) * w1[2], bfhi(vr_.w) * w1[3]);
                Vw[j] = __builtin_bit_cast(bf16x8, o);
            }
#pragma unroll
            for (int kb = 0; kb < 8; ++kb) {
                f32x4 s = Cst[kb] * decay;
#pragma unroll
                for (int j = 0; j < 4; ++j) { const bf16x8 kf = *(const LAS bf16x8*)(KT + (16 * kb + c16) * PITCH + 8 * ((4 * j + g) ^ (2 * kb + (c16 >> 3)))); s = __builtin_amdgcn_mfma_f32_16x16x32_bf16(Vw[j], kf, s, 0, 0, 0); }
                Cst[kb] = s;
#pragma unroll
                for (int i = 0; i < 4; ++i) CB[(16 * wave + 4 * g + i) * PITCH + 16 * kb + c16] = (bf16)f2bf(s[i]);
            }
            { const int k = tid & 127, part = tid >> 7; float s = 0.f;
#pragma unroll
              for (int q4 = 0; q4 < 4; ++q4) { const v4u kr_ = *(const LAS v4u*)(KT + k * PITCH + 8 * ((4 * part + q4) ^ ((k >> 3) & 15)));
                  const f32x4 w0 = *(const LAS f32x4*)(wss + 32 * part + 8 * q4), w1 = *(const LAS f32x4*)(wss + 32 * part + 8 * q4 + 4);
                  s += bflo(kr_.x) * w0[0] + bfhi(kr_.x) * w0[1] + bflo(kr_.y) * w0[2] + bfhi(kr_.y) * w0[3] + bflo(kr_.z) * w1[0] + bfhi(kr_.z) * w1[1] + bflo(kr_.w) * w1[2] + bfhi(kr_.w) * w1[3]; }
              npart[part * 128 + k] = s; }
        }
        ML_BAR();
        if (tid < 128) nst[tid] = decay * nst[tid] + ((npart[tid] + npart[128 + tid]) + (npart[256 + tid] + npart[384 + tid]));
    }
    __syncthreads();
#undef ML_LOAD_KV
#undef ML_LOAD_Q
#undef ML_LOAD_TB
#undef ML_BAR
}
constexpr int RS_OFF = 131072, RS_SLOTS = 6;
template <int MODE> __device__ __forceinline__ int stage_row_scales(const pg8::StaticOrder& S, const float* src, LAS unsigned char* lds, int tid, const float* gq = nullptr, const float* gk = nullptr) {
    pg8::Unit u0; if (!S.next(0, u0)) return 0;
    const int g0 = u0.pm >> 3, plo = u0.pm & 7; LAS float* rsl = (LAS float*)(lds + RS_OFF);
    if (gq && tid >= 256 && tid < 384) rsl[RS_SLOTS * 256 + (tid - 256)] = tid < 320 ? gq[tid - 256] : gk[tid - 320];
    if (tid < 256) {
#pragma unroll
        for (int s = 0; s < RS_SLOTS; ++s) { const int pm_s = ((g0 + s) << 3) | plo; if (pm_s < M / 256) { const int row = pm_s * 256 + tid;
            if (MODE == 0) rsl[s * 256 + tid] = src[row];
            else { const f32x4* sp = (const f32x4*)(src + (size_t)row * 16); const f32x4 s0 = sp[0], s1 = sp[1], s2 = sp[2], s3 = sp[3];
                const float tot = ((s0[0] + s0[1]) + (s0[2] + s0[3])) + ((s1[0] + s1[1]) + (s1[2] + s1[3])) + ((s2[0] + s2[1]) + (s2[2] + s2[3])) + ((s3[0] + s3[1]) + (s3[2] + s3[3]));
                rsl[s * 256 + tid] = __builtin_amdgcn_rsqf(tot * (1.0f / 1024.0f) + EPS); } } }
    }
    __syncthreads();
    return g0;
}

__global__ void __launch_bounds__(512, 2) fwd_megakernel(Args a) {
    extern __shared__ __attribute__((aligned(16))) unsigned char lds_raw[];
    LAS unsigned char* lds = (LAS unsigned char*)lds_raw;
    cg::grid_group grid = cg::this_grid();
    const int wave = __builtin_amdgcn_readfirstlane((int)threadIdx.x >> 6);
    if (threadIdx.x < 2) ((LAS unsigned*)(lds + LDS_BYTES - 32))[threadIdx.x] = 0u;
    __syncthreads();
#define GRID_BAR() do { XcdBarrier bar_; bar_.bar = (unsigned*)(kargs()->ws + WS_BAR); bar_.x = xb_xcc_id(); bar_.st = (volatile LAS unsigned*)(lds + LDS_BYTES - 32); xcd_barrier(bar_); } while (0)
#define FRESH_LANE() int lane = __builtin_amdgcn_mbcnt_hi(~0u, __builtin_amdgcn_mbcnt_lo(~0u, 0u)); asm volatile("" : "+v"(lane)); const int tid = wave * 64 + lane; (void)tid
    const int G = gridDim.x;

    if (PH & 1) { FRESH_LANE(); p0_phase(kargs(), lds, tid, lane, wave); }
    grid.sync();
    (void)xcd_barrier_post((unsigned*)(kargs()->ws + WS_BAR), (volatile LAS unsigned*)(lds + LDS_BYTES - 32));

    if (PH & 2) { FRESH_LANE(); unsigned char* ws = kargs()->ws; for (int bh = blockIdx.x; bh < 128; bh += G) cneg_scan((const float*)(ws + WS_LFA), (float*)(ws + WS_CNEG), bh, lds, tid, lane, wave);
        for (int u = (int)blockIdx.x - 128; u >= 0 && u < 64; u += G) mlstm_gate_prepass((const float*)(ws + WS_LI), (const float*)(ws + WS_LFB), (float*)(ws + WS_GB), (float*)(ws + WS_GG), (float*)(ws + WS_GM), (float*)(ws + WS_MC), u, lds, tid); }
    if (PH & 2) {
        KArgs ka = kargs(); unsigned char* ws = ka->ws;
        pg8::Gemm g{(const bf16*)(ws + WS_XB), (const bf16*)(ws + WS_BT1) + (size_t)14 * 256 * 1024, M, 2048, 1024}; pg8::StaticOrder S; S.init(M, 2048, G, (int)blockIdx.x);
        int g0; { FRESH_LANE(); g0 = stage_row_scales<0>(S, (const float*)(ws + WS_RSTD1), lds, tid, ka->in[4], ka->in[5]); }
        Epi1 E{(const LAS float*)(lds + RS_OFF), g0, (bf16*)(ws + WS_QF), (bf16*)(ws + WS_KF), (bf16*)(ws + WS_VF), (bf16*)(ws + WS_SGA), ka->in[4], ka->in[5], 14};
        pg8::gemm_phase<Epi1, pg8::StaticOrder, true, true>(lds, g, S, E, wave);
    }
    GRID_BAR();

    {
        constexpr int NML = 64;
        unsigned* const sbar = (unsigned*)(kargs()->ws + WS_CTL) + 64 * 4;
        if ((int)blockIdx.x < NML) {
            if (PH & 4) { FRESH_LANE(); mlstm_fast_unit(kargs(), (int)blockIdx.x >> 2, (int)blockIdx.x & 3, lds, tid, lane, wave); }
        } else {
            if (PH & 2) {
                KArgs ka = kargs(); unsigned char* ws = ka->ws;
                pg8::Gemm g{(const bf16*)(ws + WS_XB), (const bf16*)(ws + WS_BT1), M, 3584, 1024}; pg8::StaticOrder S; S.init(M, 3584, G - NML, (int)blockIdx.x - NML);
                int g0; { FRESH_LANE(); g0 = stage_row_scales<0>(S, (const float*)(ws + WS_RSTD1), lds, tid, ka->in[4], ka->in[5]); }
                Epi1 E{(const LAS float*)(lds + RS_OFF), g0, (bf16*)(ws + WS_QF), (bf16*)(ws + WS_KF), (bf16*)(ws + WS_VF), (bf16*)(ws + WS_SGA), ka->in[4], ka->in[5], 0};
                pg8::gemm_phase<Epi1, pg8::StaticOrder, true, true>(lds, g, S, E, wave);
            }
            asm volatile("s_waitcnt vmcnt(0)" ::: "memory");
            __syncthreads();
            { FRESH_LANE(); if (tid == 0) { __builtin_amdgcn_fence(__ATOMIC_RELEASE, "agent"); asm volatile("s_waitcnt vmcnt(0)" ::: "memory"); __hip_atomic_fetch_add(sbar, 1u, __ATOMIC_RELAXED, __HIP_MEMORY_SCOPE_AGENT); } }
        }
        { FRESH_LANE();
          if (tid == 0) { const unsigned want = (unsigned)(G - NML); while (__hip_atomic_load(sbar, __ATOMIC_RELAXED, __HIP_MEMORY_SCOPE_AGENT) < want) __builtin_amdgcn_s_sleep(8);
              __builtin_amdgcn_fence(__ATOMIC_ACQUIRE, "agent"); asm volatile("s_waitcnt vmcnt(0)" ::: "memory"); } }
        __syncthreads();
        unsigned char* ws = kargs()->ws;
        LAS unsigned* shu = (LAS unsigned*)(lds + LDS_BYTES - 64);
        const float thr2 = *(const float*)(ws + WS_CTL + 2048);
        for (;;) {
            __syncthreads();
            { FRESH_LANE(); if (tid == 0) *shu = atomicAdd((unsigned*)(ws + WS_CTL), 1u); }
            __syncthreads();
            const unsigned uu = *shu;
            if (uu >= 2048u) break;
            const int qb = 15 - (int)(uu >> 7), bh = (int)(uu & 127u);
            if (PH & 8) attn_body::attn_unit<40>(bh >> 3, bh & 7, qb, (const attn_body::bf16*)(ws + WS_QF), (const attn_body::bf16*)(ws + WS_KF), (const attn_body::bf16*)(ws + WS_VF), (attn_body::bf16*)(ws + WS_YA), (const float*)(ws + WS_CNEG), (char*)lds_raw, wave, thr2);
        }
    }
    GRID_BAR();

    if (PH & 16) {
        unsigned char* ws = kargs()->ws;
        pg8::StaticOrder S; S.init(M, 1024, G, (int)blockIdx.x);
        { pg8::Gemm g{(const bf16*)(ws + WS_YA), (const bf16*)(ws + WS_BTFO), M, 1024, 512}; EpiGate<0> E{(const bf16*)(ws + WS_SGA), (bf16*)kargs()->out};
          pg8::gemm_phase<EpiGate<0>, pg8::StaticOrder, true, true>(lds, g, S, E, wave); }
        { pg8::Gemm g{(const bf16*)(ws + WS_YB), (const bf16*)(ws + WS_BTMO), M, 1024, 512}; EpiGate<1> E{(const bf16*)(ws + WS_SGB), (bf16*)kargs()->out};
          pg8::gemm_phase<EpiGate<1>, pg8::StaticOrder, true, true>(lds, g, S, E, wave); }
    }
    GRID_BAR();

    if (PH & 32) {
        KArgs ka = kargs(); unsigned char* ws = ka->ws;
        pg8::Gemm g{(const bf16*)ka->out, (const bf16*)(ws + WS_BTO), M, 1024, 1024}; pg8::StaticOrder S; S.init(M, 1024, G, (int)blockIdx.x);
        EpiX1 E{(const bf16*)(ws + WS_XB), (bf16*)(ws + WS_X1B), (float*)(ws + WS_SSP)};
        pg8::gemm_phase<EpiX1, pg8::StaticOrder, true, true>(lds, g, S, E, wave);
    }
    GRID_BAR();

    if (PH & 64) {
        unsigned char* ws = kargs()->ws;
        pg8::Gemm g{(const bf16*)(ws + WS_X1B), (const bf16*)(ws + WS_BTGU), M, NGU, 1024}; pg8::StaticOrder S; S.init(M, NGU, G, (int)blockIdx.x);
        int g0; { FRESH_LANE(); g0 = stage_row_scales<1>(S, (const float*)(ws + WS_SSP), lds, tid); }
        EpiFFN E{(const LAS float*)(lds + RS_OFF), g0, (bf16*)(ws + WS_HMID)};
        pg8::gemm_phase<EpiFFN, pg8::StaticOrder, true, true>(lds, g, S, E, wave);
    }
    GRID_BAR();

    if (PH & 128) {
        KArgs ka = kargs(); unsigned char* ws = ka->ws;
        pg8::Gemm g{(const bf16*)(ws + WS_HMID), (const bf16*)(ws + WS_BTD), M, 1024, FF}; pg8::StaticOrder S; S.init(M, 1024, G, (int)blockIdx.x);
        EpiOut E{(const bf16*)(ws + WS_X1B), ka->out};
        pg8::gemm_phase<EpiOut, pg8::StaticOrder, true, true>(lds, g, S, E, wave);
    }
}

extern "C" void kernel_launch(void* const* d_in, const int* in_sizes, int n_in, void* d_out, int out_size, void* d_ws, size_t ws_size, hipStream_t stream) {
    static int grid = 0;
    if (grid == 0) {
        if (n_in != 18 || ws_size < WS_END) { fprintf(stderr, "kernel_launch: unexpected n_in %d / ws_size %zu\n", n_in, ws_size); grid = -1; return; }
        int dev = 0, cus = 0, per_cu = 0;
        hipGetDevice(&dev); hipDeviceGetAttribute(&cus, hipDeviceAttributeMultiprocessorCount, dev);
        hipFuncSetAttribute((const void*)fwd_megakernel, hipFuncAttributeMaxDynamicSharedMemorySize, LDS_BYTES);
        hipOccupancyMaxActiveBlocksPerMultiprocessor(&per_cu, (const void*)fwd_megakernel, 512, LDS_BYTES);
        (void)hipGetLastError();
        if (per_cu < 1) per_cu = 1;
        grid = cus;
    }
    if (grid < 0) return;
    Args a{};
    for (int i = 0; i < 18; ++i) a.in[i] = (const float*)d_in[i];
    a.out = (float*)d_out; a.ws = (unsigned char*)d_ws;
    void* args[] = {&a};
    hipError_t e = hipLaunchCooperativeKernel((const void*)fwd_megakernel, dim3(grid), dim3(512), args, LDS_BYTES, stream);
    if (e != hipSuccess) fprintf(stderr, "cooperative launch failed: %s (grid %d)\n", hipGetErrorString(e), grid);
}
```
